# Optimizing an MI355X kernel written in HIP

```python
import math
import jax, jax.numpy as jnp
from jax import lax
import numpy as np

D_MODEL = 1024
BATCH = 4
SEQ = 4096
DEPTH = 2

N_Q_HEADS = 16
N_KV_HEADS = 2
HEAD_DIM = 64
Q_PER_KV = N_Q_HEADS // N_KV_HEADS
WINDOW = 128
ATTN_BLOCK = 128
ROPE_THETA = 500000.0
ROT_DIM = HEAD_DIM // 4
SGU_WIDTH = 1024
SGU_GROUPS = 8
SGU_GROUP_DIM = SGU_WIDTH // SGU_GROUPS
SGU_CHUNK = 128
FFN_DIM = 2816
CONV_WIDTH = 3
NORM_EPS = 1e-6

Q_END = N_Q_HEADS * HEAD_DIM
K_END = Q_END + N_KV_HEADS * HEAD_DIM
V_END = K_END + N_KV_HEADS * HEAD_DIM
Z_END = V_END + 2 * SGU_WIDTH
IN_COLS = Z_END + 2 * D_MODEL

kernel_name = "hybrid_gmlp_swa_sink_convffn_adaln"


def rms_norm(x, w):
    xf = x.astype(jnp.float32)
    y = xf * lax.rsqrt(jnp.mean(xf * xf, axis=-1, keepdims=True) + NORM_EPS)
    return (y * w.astype(jnp.float32)).astype(x.dtype)


def layer_norm(x, w, b):
    xf = x.astype(jnp.float32)
    mu = jnp.mean(xf, axis=-1, keepdims=True)
    var = jnp.mean(jnp.square(xf - mu), axis=-1, keepdims=True)
    y = (xf - mu) * lax.rsqrt(var + NORM_EPS)
    return (y * w.astype(jnp.float32) + b.astype(jnp.float32)).astype(x.dtype)


def rope_tables(positions, dtype):
    inv_freq = ROPE_THETA ** (-jnp.arange(0, ROT_DIM, 2, dtype=jnp.float32) / ROT_DIM)
    ang = positions.astype(jnp.float32)[..., None] * inv_freq
    return jnp.cos(ang)[:, :, None, :].astype(dtype), jnp.sin(ang)[:, :, None, :].astype(dtype)


def apply_partial_rope(x, cos, sin):
    half = ROT_DIM // 2
    x1, x2, xp = x[..., :half], x[..., half:ROT_DIM], x[..., ROT_DIM:]
    return jnp.concatenate([x1 * cos - x2 * sin, x2 * cos + x1 * sin, xp], axis=-1)


def sliding_window_attention(q, k, v, sinks):
    B, S = q.shape[0], q.shape[1]
    nb = S // ATTN_BLOCK
    qb = q.reshape(B, nb, ATTN_BLOCK, N_KV_HEADS, Q_PER_KV, HEAD_DIM)
    kb = k.reshape(B, nb, ATTN_BLOCK, N_KV_HEADS, HEAD_DIM)
    vb = v.reshape(B, nb, ATTN_BLOCK, N_KV_HEADS, HEAD_DIM)
    pad = ((0, 0), (1, 0), (0, 0), (0, 0), (0, 0))
    k_band = jnp.concatenate([jnp.pad(kb[:, :-1], pad), kb], axis=2)
    v_band = jnp.concatenate([jnp.pad(vb[:, :-1], pad), vb], axis=2)
    scores = jnp.einsum('bnqhgd,bnkhd->bnhgqk', qb, k_band).astype(jnp.float32) * (HEAD_DIM ** -0.5)
    i = jnp.arange(ATTN_BLOCK)[:, None]
    j = jnp.arange(2 * ATTN_BLOCK)[None, :]
    band = (j > i + ATTN_BLOCK - WINDOW) & (j <= i + ATTN_BLOCK)
    exists = (jnp.arange(nb)[:, None, None] > 0) | (j >= ATTN_BLOCK)[None]
    mask = (band[None] & exists)[None, :, None, None]
    scores = jnp.where(mask, scores, -jnp.inf)
    sink = sinks.astype(jnp.float32).reshape(N_KV_HEADS, Q_PER_KV)[None, None, :, :, None, None]
    m = jnp.maximum(jnp.max(scores, axis=-1, keepdims=True), sink)
    p = jnp.exp(scores - m)
    denom = jnp.sum(p, axis=-1, keepdims=True) + jnp.exp(sink - m)
    out = jnp.einsum('bnhgqk,bnkhd->bnqhgd', (p / denom).astype(v.dtype), v_band)
    return out.reshape(B, S, N_Q_HEADS * HEAD_DIM)


def spatial_gating(z, ln_w, ln_b, w_s, b_s):
    B, S = z.shape[0], z.shape[1]
    u, v = jnp.split(z, 2, axis=-1)
    v = layer_norm(v, ln_w, ln_b)
    vb = v.reshape(B, S // SGU_CHUNK, SGU_CHUNK, SGU_GROUPS, SGU_GROUP_DIM)
    causal = jnp.tril(jnp.ones((SGU_CHUNK, SGU_CHUNK), dtype=bool))
    w = jnp.where(causal[None], w_s, jnp.zeros_like(w_s))
    f = jnp.einsum('gts,bnsgc->bntgc', w, vb) + b_s.T[None, None, :, :, None]
    return u * f.reshape(B, S, SGU_WIDTH)


def conv_ffn(h, w_gate, w_up, conv_w, conv_b, w_down):
    a = h @ w_gate
    S = a.shape[1]
    a_pad = jnp.pad(a, ((0, 0), (CONV_WIDTH - 1, 0), (0, 0)))
    a = conv_b + sum(conv_w[k] * a_pad[:, k:k + S] for k in range(CONV_WIDTH))
    return (jax.nn.silu(a) * (h @ w_up)) @ w_down


def setup_inputs(seed: int = 0) -> dict:
    key = jax.random.key(seed)
    ks = jax.random.split(key, 24)
    L, D = DEPTH, D_MODEL
    nrm = lambda k, shape, s: jax.random.normal(k, shape, jnp.float32) * s
    offsets = jax.random.randint(ks[2], (BATCH, 1), 0, 2048, dtype=jnp.int32)
    return {
        "x": nrm(ks[0], (BATCH, SEQ, D), 1.0),
        "c": nrm(ks[1], (BATCH, D), 1.0),
        "positions": offsets + jnp.arange(SEQ, dtype=jnp.int32)[None, :],
        "ada_w": nrm(ks[3], (L, D, 6 * D), D ** -0.5),
        "ada_b": nrm(ks[4], (L, 6 * D), 0.02),
        "norm1_w": 1.0 + nrm(ks[5], (L, D), 0.05),
        "w_in": nrm(ks[6], (L, D, IN_COLS), D ** -0.5),
        "attn_sinks": nrm(ks[7], (L, N_Q_HEADS), 0.5),
        "sgu_ln_w": 1.0 + nrm(ks[8], (L, SGU_WIDTH), 0.05),
        "sgu_ln_b": nrm(ks[9], (L, SGU_WIDTH), 0.02),
        "sgu_w": nrm(ks[10], (L, SGU_GROUPS, SGU_CHUNK, SGU_CHUNK), SGU_CHUNK ** -0.5),
        "sgu_b": 1.0 + nrm(ks[11], (L, SGU_GROUPS, SGU_CHUNK), 0.05),
        "proj_a": nrm(ks[12], (L, SGU_WIDTH, D), SGU_WIDTH ** -0.5),
        "proj_b": nrm(ks[13], (L, N_Q_HEADS * HEAD_DIM, D), (N_Q_HEADS * HEAD_DIM) ** -0.5),
        "w_out": nrm(ks[14], (L, D, D), D ** -0.5),
        "norm2_w": 1.0 + nrm(ks[15], (L, D), 0.05),
        "ffn_w_gate": nrm(ks[16], (L, D, FFN_DIM), D ** -0.5),
        "ffn_w_up": nrm(ks[17], (L, D, FFN_DIM), D ** -0.5),
        "ffn_conv_w": nrm(ks[18], (L, CONV_WIDTH, FFN_DIM), CONV_WIDTH ** -0.5),
        "ffn_conv_b": nrm(ks[19], (L, FFN_DIM), 0.01),
        "ffn_w_down": nrm(ks[20], (L, FFN_DIM, D), FFN_DIM ** -0.5),
        "final_norm_w": 1.0 + nrm(ks[21], (D,), 0.05),
    }


def reference(x, c, positions, ada_w, ada_b, norm1_w, w_in, attn_sinks, sgu_ln_w, sgu_ln_b, sgu_w, sgu_b,
              proj_a, proj_b, w_out, norm2_w, ffn_w_gate, ffn_w_up, ffn_conv_w, ffn_conv_b, ffn_w_down,
              final_norm_w):
    B, S = x.shape[0], x.shape[1]
    cos, sin = rope_tables(positions, x.dtype)
    c_act = jax.nn.silu(c)
    for l in range(DEPTH):
        mod = (c_act @ ada_w[l] + ada_b[l])[:, None, :]
        sh1, sc1, g1, sh2, sc2, g2 = jnp.split(mod, 6, axis=-1)
        h = rms_norm(x, norm1_w[l]) * (1 + sc1) + sh1
        proj = h @ w_in[l]
        q, k, v, z, gates = jnp.split(proj, [Q_END, K_END, V_END, Z_END], axis=-1)
        q = apply_partial_rope(q.reshape(B, S, N_Q_HEADS, HEAD_DIM), cos, sin)
        k = apply_partial_rope(k.reshape(B, S, N_KV_HEADS, HEAD_DIM), cos, sin)
        v = v.reshape(B, S, N_KV_HEADS, HEAD_DIM)
        y_attn = sliding_window_attention(q, k, v, attn_sinks[l])
        y_sgu = spatial_gating(jax.nn.gelu(z, approximate=False), sgu_ln_w[l], sgu_ln_b[l], sgu_w[l], sgu_b[l])
        gate_a, gate_b = jnp.split(jax.nn.sigmoid(gates), 2, axis=-1)
        merged = gate_a * (y_sgu @ proj_a[l]) + gate_b * (y_attn @ proj_b[l])
        x = x + g1 * (merged @ w_out[l])
        h2 = rms_norm(x, norm2_w[l]) * (1 + sc2) + sh2
        x = x + g2 * conv_ffn(h2, ffn_w_gate[l], ffn_w_up[l], ffn_conv_w[l], ffn_conv_b[l], ffn_w_down[l])
    return rms_norm(x, final_norm_w)
```

```cpp
#include <hip/hip_runtime.h>
#include <hip/hip_cooperative_groups.h>
#include <cstdio>
#include <cstdint>
#include <cmath>
#include <type_traits>
namespace cg = cooperative_groups;
namespace pg8 {
#define PG8_LAS __attribute__((address_space(3)))
typedef unsigned short bf16_t;
typedef short bf16x8 __attribute__((ext_vector_type(8)));
typedef float f32x4 __attribute__((ext_vector_type(4)));
typedef unsigned u32x4 __attribute__((ext_vector_type(4)));
constexpr int BM = 256, BK = 64, HALF = 128, HTB = HALF * BK * 2  , STAGE_BYTES = 8 * HTB, NXCD = 8, WGM = 8;

__host__ __device__ __forceinline__ int lds_byte(int r, int c) { const int st = (r >> 4) * 2 + (c >> 5), rr = r & 15, cc = c & 31, ob = rr * 64 + cc * 2; return st * 1024 + (ob ^ (((ob >> 9) & 1) << 5)); }
__host__ __device__ __forceinline__ void stage_rc(int b, int& R, int& C) { const int st = b / 1024, sb = b % 1024, swz = sb ^ (((sb >> 9) & 1) << 5); R = (st >> 1) * 16 + swz / 64; C = (st & 1) * 32 + (swz % 64) / 2; }
__host__ __device__ __forceinline__ int perm32(int rho) { const int n = rho >> 4, i = rho & 15; return 8 * (i >> 2) + 4 * n + (i & 3); }

struct Unit { int pm, pn; };
struct Gemm { const bf16_t* A; const bf16_t* Bt; int M, N, K; int a_div; size_t a_sel; };

struct StaticOrder {
    int nM, nN, nwg, G, c;
    __host__ __device__ void init(int M, int N, int G_, int c_) { nM = M / BM; nN = N / BM; nwg = nM * nN; G = G_; c = c_; }
    __host__ __device__ bool next(int i, Unit& u) const {
        const long L = (long)i * G + c; if (L >= nwg) return false;
        int wgid = (int)L; { const int q = nwg / NXCD, r = nwg % NXCD, xcd = wgid % NXCD, off = wgid / NXCD; wgid = (xcd < r ? xcd * (q + 1) : r * (q + 1) + (xcd - r) * q) + off; }
        const int nig = WGM * nN, gid = wgid / nig, fm = gid * WGM, gsz = (nM - fm) < WGM ? (nM - fm) : WGM;
        u.pm = fm + ((wgid % nig) % gsz); u.pn = (wgid % nig) / gsz; return true;
    }
    __device__ __forceinline__ void a_ready(const Unit&) const {}
    __device__ __forceinline__ void done(const Unit&) const {}
};

__device__ __forceinline__ unsigned cvt_pk_bf16(float lo, float hi) { unsigned r; asm volatile("v_cvt_pk_bf16_f32 %0, %1, %2" : "=v"(r) : "v"(lo), "v"(hi)); return r; }
typedef float f32x2 __attribute__((ext_vector_type(2)));
__device__ __forceinline__ f32x2 gelu_pk(f32x2 v) {
    const f32x2 av = __builtin_elementwise_abs(v), d = av * 0.2316418882f + 1.0f;
    f32x2 t; t.x = __builtin_amdgcn_rcpf(d.x); t.y = __builtin_amdgcn_rcpf(d.y);
    f32x2 q = t * 0.5307027145f + (-0.7265760135f); q = q * t + 0.7107068705f; q = q * t + (-0.142248368f); q = q * t + 0.127414796f; q = q * t;
    const f32x2 s = (v * v) * (-0.72134752044f);
    f32x2 e; e.x = __builtin_amdgcn_exp2f(s.x); e.y = __builtin_amdgcn_exp2f(s.y);
    const f32x2 m = v * (q * e), r = v - m;
    f32x2 o; o.x = v.x < 0.f ? m.x : r.x; o.y = v.y < 0.f ? m.y : r.y; return o;
}

template <int ACT  > struct EpiBf16 {
    static constexpr bool PERM = true, AFTER_DRAIN = false; static_assert(ACT == 0 || ACT == 1, "EpiBf16: ACT is 0 (none) or 1 (gelu_pk)");
    bf16_t* O; int ldc; const float* bias; int split_cols; size_t split_stride; float scale0;
    __device__ __forceinline__ void operator()(const f32x4 (&acc)[2][2][4][2], const Unit& u, int wr, int wc, int fr, int fq) const {
        const int row0 = u.pm * BM + wr * 64 + fr; int colt = u.pn * BM; bf16_t* base = O;
        float sc = 1.f; if (split_cols) { const int t = colt / split_cols; base += (size_t)t * split_stride; colt -= t * split_cols; if (t == 0) sc = scale0; }
        const int col0 = colt + wc * 32 + 8 * fq, bcol0 = u.pn * BM + wc * 32 + 8 * fq;
        f32x4 bv[2][2];
#pragma unroll
        for (int bj = 0; bj < 2; ++bj)
#pragma unroll
            for (int n = 0; n < 2; ++n) bv[bj][n] = bias ? *(const f32x4*)(bias + bcol0 + bj * HALF + 4 * n) : (f32x4){0.f, 0.f, 0.f, 0.f};
#pragma unroll
        for (int ai = 0; ai < 2; ++ai)
#pragma unroll
            for (int m = 0; m < 4; ++m) { bf16_t* rowp = base + (size_t)(row0 + ai * HALF + m * 16) * ldc + col0;
#pragma unroll
                for (int bj = 0; bj < 2; ++bj) { f32x4 v0 = acc[ai][bj][m][0] + bv[bj][0], v1 = acc[ai][bj][m][1] + bv[bj][1];
                    if (ACT == 1) { f32x2 a = gelu_pk((f32x2){v0[0], v0[1]}), b = gelu_pk((f32x2){v0[2], v0[3]}), c = gelu_pk((f32x2){v1[0], v1[1]}), d = gelu_pk((f32x2){v1[2], v1[3]});
                        v0 = (f32x4){a.x, a.y, b.x, b.y}; v1 = (f32x4){c.x, c.y, d.x, d.y}; }
                    v0 = v0 * sc; v1 = v1 * sc; u32x4 w; w.x = cvt_pk_bf16(v0[0], v0[1]); w.y = cvt_pk_bf16(v0[2], v0[3]); w.z = cvt_pk_bf16(v1[0], v1[1]); w.w = cvt_pk_bf16(v1[2], v1[3]);
                    *(u32x4*)(rowp + bj * HALF) = w; } }
    }
};
template <class Epi, class Sched, bool ALIGN_EPI = false, bool SP2 = false>
__device__ __forceinline__ void gemm_phase(PG8_LAS unsigned char* lds, const Gemm g, const Sched& S, const Epi& E) {
    int tid_ = threadIdx.x; asm volatile("" : "+v"(tid_));
    const int tid = tid_, wid = __builtin_amdgcn_readfirstlane(tid >> 6), lane = tid & 63, wr = wid >> 2, wc = wid & 3, fr = lane & 15, fq = lane >> 4;
    const int K = g.K, nt = K / BK;
    unsigned voffA[2], voffB[2];
#pragma unroll
    for (int i = 0; i < 2; ++i) { int R, C; stage_rc(tid * 16 + i * 8192, R, C); const int Rb = Epi::PERM ? ((R & ~31) + perm32(R & 31)) : R;
        voffA[i] = (unsigned)(R * K + C) * 2u; voffB[i] = (unsigned)(Rb * K + C) * 2u; }
    const size_t kstep = (size_t)(BK * 2);
    const size_t hstep = (size_t)HALF * K * 2;
    const size_t tstep = 2 * hstep;
    const unsigned ldsw = (unsigned)wid * 1024u;
    const int aoff = lds_byte(wr * 64 + fr, fq * 8), boff = lds_byte(wc * 32 + fr, fq * 8);
#define PG8_SA(b, h) (((b) * 2 + (h)) * HTB)
#define PG8_SB(b, h) ((4 + (b) * 2 + (h)) * HTB)
#define PG8_STAGE(bufoff, gbase, voff) do { _Pragma("unroll") for (int _i = 0; _i < 2; ++_i) \
        __builtin_amdgcn_global_load_lds((const unsigned*)((const char*)(gbase) + (voff)[_i]), (PG8_LAS unsigned*)(lds + (bufoff) + ldsw + _i * 8192), 16, 0, 0); } while (0)
#define PG8_LDA(dst, b, h) do { _Pragma("unroll") for (int m = 0; m < 4; ++m) _Pragma("unroll") for (int k = 0; k < 2; ++k) dst[m][k] = *(const PG8_LAS bf16x8*)(lds + PG8_SA(b, h) + aoff + m * 2048 + k * 1024); } while (0)
#define PG8_LDB(dst, b, h) do { _Pragma("unroll") for (int n = 0; n < 2; ++n) _Pragma("unroll") for (int k = 0; k < 2; ++k) dst[n][k] = *(const PG8_LAS bf16x8*)(lds + PG8_SB(b, h) + boff + n * 2048 + k * 1024); } while (0)
#define PG8_MMA(ai, bj, At, Bt) do { __builtin_amdgcn_s_setprio(1); _Pragma("unroll") for (int m = 0; m < 4; ++m) _Pragma("unroll") for (int n = 0; n < 2; ++n) _Pragma("unroll") for (int k = 0; k < 2; ++k) \
        acc[ai][bj][m][n] = __builtin_amdgcn_mfma_f32_16x16x32_bf16(Bt[n][k], At[m][k], acc[ai][bj][m][n], 0, 0, 0); __builtin_amdgcn_s_setprio(0); } while (0)
#define PG8_WAIT_V(n) asm volatile("s_waitcnt vmcnt(" #n ")" ::: "memory")
#define PG8_WAIT_L(n) asm volatile("s_waitcnt lgkmcnt(" #n ")" ::: "memory")
#define PG8_BAR __builtin_amdgcn_s_barrier()
#define PG8_SCHED __builtin_amdgcn_sched_barrier(0)
    Unit cur, nxt; int ui = 0;
    if (!S.next(0, cur)) return;
    f32x4 acc[2][2][4][2];
#pragma unroll
    for (int a = 0; a < 2; ++a)
#pragma unroll
        for (int b = 0; b < 2; ++b)
#pragma unroll
            for (int m = 0; m < 4; ++m)
#pragma unroll
                for (int n = 0; n < 2; ++n) acc[a][b][m][n] = (f32x4){0.f, 0.f, 0.f, 0.f};
    bf16x8 At[4][2], B0[2][2], B1[2][2];
    const char* cA = (const char*)g.A + (size_t)cur.pm * tstep + (size_t)(cur.pn / g.a_div) * g.a_sel; const char* cB = (const char*)g.Bt + (size_t)cur.pn * tstep;
    S.a_ready(cur);
    if constexpr (SP2) {
        PG8_STAGE(PG8_SB(0, 0), cB, voffB); PG8_STAGE(PG8_SB(0, 1), cB + hstep, voffB); PG8_STAGE(PG8_SA(0, 0), cA, voffA); PG8_STAGE(PG8_SA(0, 1), cA + hstep, voffA);
        if (wr == 1) PG8_BAR;
        PG8_WAIT_V(2); PG8_BAR;
        PG8_STAGE(PG8_SB(1, 0), cB + kstep, voffB); PG8_STAGE(PG8_SA(1, 0), cA + kstep, voffA); PG8_STAGE(PG8_SB(1, 1), cB + hstep + kstep, voffB);
        PG8_WAIT_V(6); PG8_BAR;
    } else {
        PG8_STAGE(PG8_SB(0, 0), cB, voffB); PG8_STAGE(PG8_SA(0, 0), cA, voffA); PG8_STAGE(PG8_SB(0, 1), cB + hstep, voffB); PG8_STAGE(PG8_SA(0, 1), cA + hstep, voffA);
        if (wr == 1) PG8_BAR;
        PG8_WAIT_V(4); PG8_BAR;
        PG8_STAGE(PG8_SB(1, 0), cB + kstep, voffB); PG8_STAGE(PG8_SA(1, 0), cA + kstep, voffA); PG8_STAGE(PG8_SB(1, 1), cB + hstep + kstep, voffB);
        PG8_WAIT_V(6); PG8_BAR;
    }
    for (;;) {
        const bool has_next = S.next(ui + 1, nxt);
        const char* nA = has_next ? (const char*)g.A + (size_t)nxt.pm * tstep + (size_t)(nxt.pn / g.a_div) * g.a_sel : cA; const char* nB = has_next ? (const char*)g.Bt + (size_t)nxt.pn * tstep : cB;
        for (int t = 0; t < nt; t += 2) {
            const bool last = (t == nt - 2);
            const char* a1 = cA + (size_t)(t + 1) * kstep;
            const char* a2 = last ? nA : cA + (size_t)(t + 2) * kstep; const char* b2 = last ? nB : cB + (size_t)(t + 2) * kstep;
            const char* a3 = a2 + kstep; const char* b3 = b2 + kstep;
            if (last && has_next) S.a_ready(nxt);
            if constexpr (SP2) {
            PG8_LDB(B0, 0, 0); PG8_LDB(B1, 0, 1); PG8_SCHED; PG8_LDA(At, 0, 0); PG8_STAGE(PG8_SA(1, 1), a1 + hstep, voffA);
            PG8_WAIT_V(8); PG8_WAIT_L(0); PG8_BAR; PG8_MMA(0, 0, At, B0); PG8_MMA(0, 1, At, B1); PG8_BAR; PG8_SCHED;
            PG8_LDA(At, 0, 1); PG8_STAGE(PG8_SB(0, 0), b2, voffB); PG8_STAGE(PG8_SB(0, 1), b2 + hstep, voffB); PG8_STAGE(PG8_SA(0, 0), a2, voffA);
            PG8_WAIT_V(8); PG8_WAIT_L(0); PG8_BAR; PG8_MMA(1, 0, At, B0); PG8_MMA(1, 1, At, B1); PG8_BAR; PG8_SCHED;
            PG8_LDB(B0, 1, 0); PG8_LDB(B1, 1, 1); PG8_SCHED; PG8_LDA(At, 1, 0); PG8_STAGE(PG8_SA(0, 1), a2 + hstep, voffA);
            PG8_WAIT_V(8); PG8_WAIT_L(0); PG8_BAR; PG8_MMA(0, 0, At, B0); PG8_MMA(0, 1, At, B1); PG8_BAR; PG8_SCHED;
            PG8_LDA(At, 1, 1); PG8_STAGE(PG8_SB(1, 0), b3, voffB); PG8_STAGE(PG8_SB(1, 1), b3 + hstep, voffB); PG8_STAGE(PG8_SA(1, 0), a3, voffA);
            PG8_WAIT_V(8); PG8_WAIT_L(0); PG8_BAR; PG8_MMA(1, 0, At, B0); PG8_MMA(1, 1, At, B1); PG8_BAR; PG8_SCHED;
            } else {
            PG8_LDB(B0, 0, 0); PG8_SCHED; PG8_LDA(At, 0, 0); PG8_STAGE(PG8_SA(1, 1), a1 + hstep, voffA);
            PG8_WAIT_L(8); PG8_BAR; PG8_WAIT_L(0); PG8_MMA(0, 0, At, B0); PG8_BAR; PG8_SCHED;
            PG8_LDB(B1, 0, 1); PG8_STAGE(PG8_SB(0, 0), b2, voffB);
            PG8_BAR; PG8_WAIT_L(0); PG8_MMA(0, 1, At, B1); PG8_BAR;
            PG8_LDA(At, 0, 1); PG8_STAGE(PG8_SA(0, 0), a2, voffA);
            PG8_BAR; PG8_WAIT_L(0); PG8_MMA(1, 0, At, B0); PG8_BAR; PG8_SCHED;
            PG8_STAGE(PG8_SB(0, 1), b2 + hstep, voffB);
            PG8_WAIT_V(6); PG8_BAR; PG8_MMA(1, 1, At, B1); PG8_BAR;
            PG8_LDB(B0, 1, 0); PG8_SCHED; PG8_LDA(At, 1, 0); PG8_STAGE(PG8_SA(0, 1), a2 + hstep, voffA);
            PG8_WAIT_L(8); PG8_BAR; PG8_WAIT_L(0); PG8_MMA(0, 0, At, B0); PG8_BAR; PG8_SCHED;
            PG8_LDB(B1, 1, 1); PG8_STAGE(PG8_SB(1, 0), b3, voffB);
            PG8_BAR; PG8_WAIT_L(0); PG8_MMA(0, 1, At, B1); PG8_BAR;
            PG8_LDA(At, 1, 1); PG8_STAGE(PG8_SA(1, 0), a3, voffA);
            PG8_BAR; PG8_WAIT_L(0); PG8_MMA(1, 0, At, B0); PG8_BAR; PG8_SCHED;
            PG8_STAGE(PG8_SB(1, 1), b3 + hstep, voffB);
            PG8_WAIT_V(6); PG8_BAR; PG8_MMA(1, 1, At, B1); PG8_BAR;
            }
        }
        if constexpr (ALIGN_EPI) { if (wr == 0) PG8_BAR; }
        if constexpr (!Epi::AFTER_DRAIN) { E(acc, cur, wr, wc, fr, fq); S.done(cur); }
        if (!has_next) break;
#pragma unroll
        for (int a = 0; a < 2; ++a)
#pragma unroll
            for (int b = 0; b < 2; ++b)
#pragma unroll
                for (int m = 0; m < 4; ++m)
#pragma unroll
                    for (int n = 0; n < 2; ++n) acc[a][b][m][n] = (f32x4){0.f, 0.f, 0.f, 0.f};
        cur = nxt; cA = nA; cB = nB; ++ui;
        if constexpr (ALIGN_EPI) { if (wr == 1) PG8_BAR; }
    }
    PG8_WAIT_V(0);
    if constexpr (!ALIGN_EPI) { if (wr == 0) PG8_BAR; }
    PG8_BAR;
    if constexpr (Epi::AFTER_DRAIN) { E.fused(acc, cur, wr, wc, fr, fq, lds, wid, lane); S.done(cur); }
#undef PG8_SA
#undef PG8_SB
#undef PG8_STAGE
#undef PG8_LDA
#undef PG8_LDB
#undef PG8_MMA
#undef PG8_WAIT_V
#undef PG8_WAIT_L
#undef PG8_BAR
#undef PG8_SCHED
}
}
namespace pg8 {
__device__ __forceinline__ float bf_lo(unsigned w) { return __uint_as_float(w << 16); }
__device__ __forceinline__ float bf_hi(unsigned w) { return __uint_as_float(w & 0xffff0000u); }
__device__ __forceinline__ float sigm(float v) { return __builtin_amdgcn_rcpf(1.0f + __expf(-v)); }
__device__ __forceinline__ u32x4 pack8(f32x4 v0, f32x4 v1) { u32x4 w; w.x = cvt_pk_bf16(v0[0], v0[1]); w.y = cvt_pk_bf16(v0[2], v0[3]); w.z = cvt_pk_bf16(v1[0], v1[1]); w.w = cvt_pk_bf16(v1[2], v1[3]); return w; }

struct EpiInProj {
    static constexpr bool PERM = true, AFTER_DRAIN = false;
    bf16_t *Q, *Kb, *Vb, *U, *VS, *GA, *GB; const float* rope;
    __device__ __forceinline__ void operator()(const f32x4 (&acc)[2][2][4][2], const Unit& u, int wr, int wc, int fr, int fq) const {
        const int pn = u.pn, row0 = u.pm * BM + wr * 64 + fr, cl = wc * 32 + 8 * fq;
        int kind, ldc; bf16_t *b0, *b1;
        if (pn < 4)       { kind = 0; ldc = 1024; b0 = Q + pn * 256 + cl; b1 = b0 + 128; }
        else if (pn == 4) { kind = 1; ldc = 128;  b0 = Kb + cl; b1 = Vb + cl; }
        else if (pn < 9)  { kind = 2; ldc = 1024; b0 = U + (pn - 5) * 256 + cl; b1 = b0 + 128; }
        else if (pn < 13) { kind = 2; ldc = 1024; b0 = VS + (pn - 9) * 256 + cl; b1 = b0 + 128; }
        else if (pn < 17) { kind = 3; ldc = 1024; b0 = GA + (pn - 13) * 256 + cl; b1 = b0 + 128; }
        else              { kind = 3; ldc = 1024; b0 = GB + (pn - 17) * 256 + cl; b1 = b0 + 128; }
        const bool ropelane = ((wc & 1) == 0) && (fq < 2);
        const float sgn = (fq == 0) ? -1.f : 1.f;
#pragma unroll
        for (int ai = 0; ai < 2; ++ai)
#pragma unroll
            for (int m = 0; m < 4; ++m) {
                const int row = row0 + ai * HALF + m * 16;
                f32x4 c0 = {1.f, 1.f, 1.f, 1.f}, c1 = c0, s0 = {0.f, 0.f, 0.f, 0.f}, s1 = s0;
                if (kind <= 1 && ropelane) { const f32x4* rp = (const f32x4*)(rope + (size_t)row * 16); c0 = rp[0]; c1 = rp[1]; s0 = rp[2]; s1 = rp[3]; }
#pragma unroll
                for (int bj = 0; bj < 2; ++bj) {
                    f32x4 v0 = acc[ai][bj][m][0], v1 = acc[ai][bj][m][1];
                    if (kind == 0 || (kind == 1 && bj == 0)) {
                        f32x4 p0, p1;
#pragma unroll
                        for (int i = 0; i < 4; ++i) { p0[i] = __shfl_xor(v0[i], 16); p1[i] = __shfl_xor(v1[i], 16); }
                        v0 = v0 * c0 + (p0 * s0) * sgn; v1 = v1 * c1 + (p1 * s1) * sgn;
                        if (kind == 0) { v0 = v0 * 0.125f; v1 = v1 * 0.125f; }
                    } else if (kind == 2) {
                        f32x2 a = gelu_pk((f32x2){v0[0], v0[1]}), b = gelu_pk((f32x2){v0[2], v0[3]}), c = gelu_pk((f32x2){v1[0], v1[1]}), d = gelu_pk((f32x2){v1[2], v1[3]});
                        v0 = (f32x4){a.x, a.y, b.x, b.y}; v1 = (f32x4){c.x, c.y, d.x, d.y};
                    } else if (kind == 3) {
#pragma unroll
                        for (int i = 0; i < 4; ++i) { v0[i] = sigm(v0[i]); v1[i] = sigm(v1[i]); }
                    }
                    *(u32x4*)((bj ? b1 : b0) + (size_t)row * ldc) = pack8(v0, v1);
                }
            }
    }
};
struct EpiGateMul {
    static constexpr bool PERM = true, AFTER_DRAIN = false;
    bf16_t* T; const bf16_t *GA, *GB;
    __device__ __forceinline__ void operator()(const f32x4 (&acc)[2][2][4][2], const Unit& u, int wr, int wc, int fr, int fq) const {
        const int pn = u.pn, row0 = u.pm * BM + wr * 64 + fr, cl = wc * 32 + 8 * fq;
        const bf16_t* G = (pn < 4 ? GB : GA) + (pn & 3) * 256 + cl; bf16_t* O = T + pn * 256 + cl;
#pragma unroll
        for (int ai = 0; ai < 2; ++ai)
#pragma unroll
            for (int m = 0; m < 4; ++m) {
                const int row = row0 + ai * HALF + m * 16;
#pragma unroll
                for (int bj = 0; bj < 2; ++bj) {
                    const u32x4 g = *(const u32x4*)(G + (size_t)row * 1024 + bj * HALF);
                    const f32x4 g0 = {bf_lo(g.x), bf_hi(g.x), bf_lo(g.y), bf_hi(g.y)}, g1 = {bf_lo(g.z), bf_hi(g.z), bf_lo(g.w), bf_hi(g.w)};
                    *(u32x4*)(O + (size_t)row * 2048 + bj * HALF) = pack8(acc[ai][bj][m][0] * g0, acc[ai][bj][m][1] * g1);
                }
            }
    }
};
struct EpiResid {
    static constexpr bool PERM = false, AFTER_DRAIN = false;
    const float* xin; float* out; const float* g;
    __device__ __forceinline__ void operator()(const f32x4 (&acc)[2][2][4][2], const Unit& u, int wr, int wc, int fr, int fq) const {
        const int row0 = u.pm * BM + wr * 64 + fr, col0 = u.pn * BM + wc * 32 + 4 * fq, b = u.pm >> 4;
        f32x4 gv[2][2];
#pragma unroll
        for (int bj = 0; bj < 2; ++bj)
#pragma unroll
            for (int n = 0; n < 2; ++n) gv[bj][n] = *(const f32x4*)(g + (size_t)b * 6144 + col0 + bj * HALF + n * 16);
#pragma unroll
        for (int ai = 0; ai < 2; ++ai)
#pragma unroll
            for (int m = 0; m < 4; ++m) {
                const size_t off = (size_t)(row0 + ai * HALF + m * 16) * 1024 + col0;
#pragma unroll
                for (int bj = 0; bj < 2; ++bj)
#pragma unroll
                    for (int n = 0; n < 2; ++n) { const f32x4 x = *(const f32x4*)(xin + off + bj * HALF + n * 16); *(f32x4*)(out + off + bj * HALF + n * 16) = x + gv[bj][n] * acc[ai][bj][m][n]; }
            }
    }
};
__device__ __forceinline__ float dpp_ctl_shl15(float v) { return __int_as_float(__builtin_amdgcn_update_dpp(0, __float_as_int(v), 0x10F, 0xF, 0xF, false)); }
__device__ __forceinline__ float dpp_ctl_shl14(float v) { return __int_as_float(__builtin_amdgcn_update_dpp(0, __float_as_int(v), 0x10E, 0xF, 0xF, false)); }
__device__ __forceinline__ float dpp_ctl_shr1(float old, float v) { return __int_as_float(__builtin_amdgcn_update_dpp(__float_as_int(old), __float_as_int(v), 0x111, 0xF, 0xF, false)); }
__device__ __forceinline__ float dpp_ctl_shr2(float old, float v) { return __int_as_float(__builtin_amdgcn_update_dpp(__float_as_int(old), __float_as_int(v), 0x112, 0xF, 0xF, false)); }
struct EpiGUConv {
    static constexpr bool PERM = true, AFTER_DRAIN = false;
    bf16_t* ACT; float *RAWA, *RAWU, *TAILA; const float *cw, *cb; PG8_LAS unsigned char* xch;
    __device__ __forceinline__ void operator()(const f32x4 (&acc)[2][2][4][2], const Unit& u, int wr, int wc, int fr, int fq) const {
        const int cl = wc * 32 + 8 * fq, f0 = u.pn * 128 + cl;
        PG8_LAS float* X = (PG8_LAS float*)xch;
        if (fr >= 14) {
#pragma unroll
            for (int ai = 0; ai < 2; ++ai) { PG8_LAS float* p = X + ((ai * 2 + wr) * 2 + (fr - 14)) * 128 + cl; *(PG8_LAS f32x4*)p = acc[ai][0][3][0]; *(PG8_LAS f32x4*)(p + 4) = acc[ai][0][3][1]; }
            if (wr == 1) { float* t = TAILA + ((size_t)u.pm * 2 + (fr - 14)) * 2816 + f0; *(f32x4*)t = acc[1][0][3][0]; *(f32x4*)(t + 4) = acc[1][0][3][1]; }
        }
        if (wr == 0 && fr < 2) { const size_t o = ((size_t)u.pm * 2 + fr) * 2816 + f0;
            *(f32x4*)(RAWA + o) = acc[0][0][0][0]; *(f32x4*)(RAWA + o + 4) = acc[0][0][0][1]; *(f32x4*)(RAWU + o) = acc[0][1][0][0]; *(f32x4*)(RAWU + o + 4) = acc[0][1][0][1]; }
        asm volatile("s_waitcnt lgkmcnt(0)" ::: "memory"); __builtin_amdgcn_s_barrier(); asm volatile("" ::: "memory");
        f32x4 k0[2], k1[2], k2[2], kb[2];
#pragma unroll
        for (int n = 0; n < 2; ++n) { k0[n] = *(const f32x4*)(cw + f0 + 4 * n); k1[n] = *(const f32x4*)(cw + 2816 + f0 + 4 * n); k2[n] = *(const f32x4*)(cw + 2 * 2816 + f0 + 4 * n); kb[n] = *(const f32x4*)(cb + f0 + 4 * n); }
        const int row0 = u.pm * BM + wr * 64 + fr;
#pragma unroll
        for (int ai = 0; ai < 2; ++ai) {
            f32x4 P[2] = {{0.f, 0.f, 0.f, 0.f}, {0.f, 0.f, 0.f, 0.f}};
            if (!(ai == 0 && wr == 0) && fr >= 14) { const int pai = (wr == 1) ? ai : ai - 1, pwr = (wr == 1) ? 0 : 1;
                const PG8_LAS float* p = X + ((pai * 2 + pwr) * 2 + (fr - 14)) * 128 + cl; P[0] = *(const PG8_LAS f32x4*)p; P[1] = *(const PG8_LAS f32x4*)(p + 4); }
#pragma unroll
            for (int m = 0; m < 4; ++m) {
                f32x4 r[2];
#pragma unroll
                for (int n = 0; n < 2; ++n)
#pragma unroll
                    for (int i = 0; i < 4; ++i) {
                        const float cur = acc[ai][0][m][n][i], prev = (m == 0) ? P[n][i] : acc[ai][0][m == 0 ? 0 : m - 1][n][i];
                        const float p1 = dpp_ctl_shr1(dpp_ctl_shl15(prev), cur), p2 = dpp_ctl_shr2(dpp_ctl_shl14(prev), cur);
                        const float cv = kb[n][i] + k0[n][i] * p2 + k1[n][i] * p1 + k2[n][i] * cur;
                        r[n][i] = cv * sigm(cv) * acc[ai][1][m][n][i];
                    }
                *(u32x4*)(ACT + (size_t)(row0 + ai * HALF + m * 16) * 2816 + f0) = pack8(r[0], r[1]);
            }
        }
    }
};
}
#define LAS __attribute__((address_space(3)))
typedef unsigned short bf16;
typedef unsigned v4u __attribute__((ext_vector_type(4)));
typedef unsigned v2u __attribute__((ext_vector_type(2)));
typedef float f32x4 __attribute__((ext_vector_type(4)));
using pg8::bf_lo; using pg8::bf_hi; using pg8::cvt_pk_bf16;

constexpr int M = 16384, D = 1024, SEQ = 4096, INC = 5376, FF = 2816, NL = 2;
constexpr size_t MiB = 1u << 20;
constexpr size_t WS_MOD = 0, WS_ROPE = 1 * MiB, WS_RAWA = 2 * MiB, WS_RAWU = 3 * MiB + 512 * 1024, WS_TAILA = 5 * MiB;
constexpr size_t WS_W = 8 * MiB, WS_WIN = WS_W, WS_PAB = WS_W + 10 * MiB + 512 * 1024, WS_WO2 = WS_PAB + 4 * MiB, WS_WGU = WS_WO2 + 4 * MiB, WS_WD = WS_WGU + 11 * MiB;
constexpr size_t WS_H = 43 * MiB, WS_VS = 75 * MiB, WS_T = 43 * MiB, WS_Q = 107 * MiB, WS_K = 139 * MiB, WS_V = 143 * MiB, WS_U = 147 * MiB, WS_GA = 179 * MiB, WS_GB = 211 * MiB;
constexpr size_t WS_ACT = 107 * MiB, WS_END = 256 * MiB;
static_assert(WS_WD + (size_t)D * FF * 2 <= WS_H && WS_GB + 32 * MiB <= WS_END && WS_ACT + 88 * MiB <= WS_END && WS_TAILA + 3 * MiB / 2 <= WS_W, "ws map");
constexpr int LDS_BYTES = 147456;
#define LDS_WAIT() asm volatile("s_waitcnt lgkmcnt(0)" ::: "memory")

__device__ __forceinline__ unsigned f2bf(float f) { unsigned u = __builtin_bit_cast(unsigned, f); return (u + 0x7fffu + ((u >> 16) & 1u)) >> 16; }
__device__ __forceinline__ unsigned pk2(float lo, float hi) { return f2bf(lo) | (f2bf(hi) << 16); }
__device__ __forceinline__ float wave_sum(float v) {
#pragma unroll
    for (int o = 1; o < 64; o <<= 1) v += __shfl_xor(v, o);
    return v;
}
__device__ __forceinline__ void tr_item(const float* W, int N, bf16* WT, int dpitch, int koff, int drow0, int k0, int n0, LAS float* scr, int lane) {
#pragma unroll 8
    for (int i = 0; i < 32; ++i) { const int kk = 2 * i + (lane >> 5); scr[kk * 33 + (lane & 31)] = W[(size_t)(k0 + kk) * N + n0 + (lane & 31)]; }
    LDS_WAIT(); asm volatile("" ::: "memory");
    const int c = lane & 7;
#pragma unroll
    for (int j = 0; j < 4; ++j) { const int n = (lane >> 3) + 8 * j; const LAS float* s = scr + (8 * c) * 33 + n;
        v4u o; o.x = pk2(s[0 * 33], s[1 * 33]); o.y = pk2(s[2 * 33], s[3 * 33]); o.z = pk2(s[4 * 33], s[5 * 33]); o.w = pk2(s[6 * 33], s[7 * 33]);
        *(v4u*)(WT + (size_t)(drow0 + n) * dpitch + koff + k0 + 8 * c) = o; }
    LDS_WAIT(); asm volatile("" ::: "memory");
}

typedef short bf16x8_t __attribute__((ext_vector_type(8)));
constexpr int ATT_KP = 144, ATT_VP = 528, ATT_VOFF = 256 * ATT_KP;
constexpr int SGU_STAT = 0, SGU_VT = 1024, SGU_VP = 272, SGU_WREG = 64 * SGU_VP;
static_assert(ATT_VOFF + 64 * ATT_VP <= 131072 && SGU_VT + 8 * SGU_WREG <= LDS_BYTES, "mixer LDS maps");

__device__ __forceinline__ void attn_unit(LAS unsigned char* lds, bf16* Q, const bf16* Kg, const bf16* Vg, const float* snk, int unit, int tid) {
    const int lane = tid & 63, wave = tid >> 6, fr = lane & 15, fq = lane >> 4;
    const int b = unit >> 6, n = (unit >> 1) & 31, h = unit & 1, r0 = b * SEQ + n * 128, hq = 8 * h + wave;
    const v4u zero4 = {0u, 0u, 0u, 0u};
    bf16* qbase = Q + (size_t)(r0 + fr) * 1024 + hq * 64;
    bf16x8_t qf[8][2];
#pragma unroll
    for (int mt = 0; mt < 8; ++mt) { qf[mt][0] = *(const bf16x8_t*)(qbase + (size_t)mt * 16 * 1024 + 8 * fq); qf[mt][1] = *(const bf16x8_t*)(qbase + (size_t)mt * 16 * 1024 + 32 + 8 * fq); }
#pragma unroll
    for (int i = 0; i < 4; ++i) { const int idx = tid + 512 * i, j = idx >> 3, c = idx & 7, p = n * 128 - 128 + j;
        v4u w = zero4; if (p >= 0) w = *(const v4u*)(Kg + (size_t)(b * SEQ + p) * 128 + h * 64 + c * 8);
        *(LAS v4u*)(lds + j * ATT_KP + c * 16) = w; }
#pragma unroll
    for (int i = 0; i < 2; ++i) { const int idx = tid + 512 * i, j = (idx >> 3) * 2, c = idx & 7, p = n * 128 - 128 + j;
        v4u w0 = zero4, w1 = zero4;
        if (p >= 0) { w0 = *(const v4u*)(Vg + (size_t)(b * SEQ + p) * 128 + h * 64 + c * 8); w1 = *(const v4u*)(Vg + (size_t)(b * SEQ + p + 1) * 128 + h * 64 + c * 8); }
        const unsigned A0[4] = {w0.x, w0.y, w0.z, w0.w}, A1[4] = {w1.x, w1.y, w1.z, w1.w};
#pragma unroll
        for (int e = 0; e < 8; ++e) { const unsigned lo = (e & 1) ? (A0[e >> 1] >> 16) : (A0[e >> 1] & 0xffffu), hi = (e & 1) ? (A1[e >> 1] & 0xffff0000u) : (A1[e >> 1] << 16);
            *(LAS unsigned*)(lds + ATT_VOFF + (8 * c + e) * ATT_VP + j * 2) = lo | hi; } }
    __syncthreads();
    const float sink = snk[hq];
    bool lo_ok[4];
#pragma unroll
    for (int i = 0; i < 4; ++i) lo_ok[i] = (4 * fq + i - fr) > 0;
#pragma unroll
    for (int mt = 0; mt < 8; ++mt) {
        f32x4 st[9];
#pragma unroll
        for (int kb = 0; kb < 9; ++kb) { const LAS unsigned char* kp = lds + (16 * (mt + kb) + fr) * ATT_KP + 16 * fq;
            const bf16x8_t k0 = *(const LAS bf16x8_t*)kp, k1 = *(const LAS bf16x8_t*)(kp + 64);
            f32x4 z = {0.f, 0.f, 0.f, 0.f}; z = __builtin_amdgcn_mfma_f32_16x16x32_bf16(k0, qf[mt][0], z, 0, 0, 0); z = __builtin_amdgcn_mfma_f32_16x16x32_bf16(k1, qf[mt][1], z, 0, 0, 0); st[kb] = z; }
        float mx = sink;
#pragma unroll
        for (int kb = 0; kb < 9; ++kb) {
            const bool tile_ok = (n > 0) || (mt + kb >= 8);
#pragma unroll
            for (int i = 0; i < 4; ++i) { const bool ok = tile_ok && (kb == 0 ? lo_ok[i] : (kb == 8 ? !lo_ok[i] : true));
                st[kb][i] = ok ? st[kb][i] : -INFINITY; mx = fmaxf(mx, st[kb][i]); }
        }
        mx = fmaxf(mx, __shfl_xor(mx, 16)); mx = fmaxf(mx, __shfl_xor(mx, 32));
        float ls = 0.f;
#pragma unroll
        for (int kb = 0; kb < 9; ++kb)
#pragma unroll
            for (int i = 0; i < 4; ++i) { const float p = __expf(st[kb][i] - mx); st[kb][i] = p; ls += p; }
        ls += __shfl_xor(ls, 16); ls += __shfl_xor(ls, 32);
        const float inv = 1.f / (ls + __expf(sink - mx));
        f32x4 o[4];
#pragma unroll
        for (int dt = 0; dt < 4; ++dt) o[dt] = (f32x4){0.f, 0.f, 0.f, 0.f};
#pragma unroll
        for (int kp = 0; kp < 5; ++kp) {
            v4u pw; pw.x = cvt_pk_bf16(st[2 * kp][0], st[2 * kp][1]); pw.y = cvt_pk_bf16(st[2 * kp][2], st[2 * kp][3]);
            if (kp < 4) { pw.z = cvt_pk_bf16(st[(2 * kp + 1) % 9][0], st[(2 * kp + 1) % 9][1]); pw.w = cvt_pk_bf16(st[(2 * kp + 1) % 9][2], st[(2 * kp + 1) % 9][3]); } else { pw.z = 0u; pw.w = 0u; }
            const bf16x8_t pb = __builtin_bit_cast(bf16x8_t, pw);
#pragma unroll
            for (int dt = 0; dt < 4; ++dt) { const LAS unsigned char* vp = lds + ATT_VOFF + (16 * dt + fr) * ATT_VP + (16 * (mt + 2 * kp) + 4 * fq) * 2;
                const v2u lo = *(const LAS v2u*)vp; v2u hi = {0u, 0u}; if (kp < 4) hi = *(const LAS v2u*)(vp + 32);
                v4u aw; aw.x = lo.x; aw.y = lo.y; aw.z = hi.x; aw.w = hi.y;
                o[dt] = __builtin_amdgcn_mfma_f32_16x16x32_bf16(__builtin_bit_cast(bf16x8_t, aw), pb, o[dt], 0, 0, 0); }
        }
#pragma unroll
        for (int dt = 0; dt < 4; ++dt) { const f32x4 y = o[dt] * inv; v2u w; w.x = cvt_pk_bf16(y[0], y[1]); w.y = cvt_pk_bf16(y[2], y[3]); *(v2u*)(qbase + (size_t)mt * 16 * 1024 + 16 * dt + 4 * fq) = w; }
    }
    __syncthreads();
}

__device__ __forceinline__ void sgu_unit(LAS unsigned char* lds, bf16* U, const bf16* VS, const float* lnw, const float* lnb, const float* Wl, const float* bsl, int unit, int tid) {
    const int lane = tid & 63, wave = tid >> 6, fr = lane & 15, fq = lane >> 4;
    const int ch = unit >> 1, hf = unit & 1, r0 = ch * 128, g = 4 * hf + (wave >> 1), colbase = g * 128 + (wave & 1) * 64;
    LAS float* stat = (LAS float*)(lds + SGU_STAT);
    const float* Wg = Wl + (size_t)g * 128 * 128;
    v4u wfr[20]; float bbv[8];
    {
        int q = 0;
#pragma unroll
        for (int mt = 0; mt < 8; ++mt) {
            const int t = 16 * mt + fr; bbv[mt] = bsl[g * 128 + t];
#pragma unroll
            for (int ks = 0; ks <= (mt >> 1); ++ks) {
                const int sb = 32 * ks + 8 * fq;
                const f32x4 wa = *(const f32x4*)(Wg + (size_t)t * 128 + sb), wb = *(const f32x4*)(Wg + (size_t)t * 128 + sb + 4);
                v4u ww;
                ww.x = cvt_pk_bf16(sb + 0 <= t ? wa.x : 0.f, sb + 1 <= t ? wa.y : 0.f); ww.y = cvt_pk_bf16(sb + 2 <= t ? wa.z : 0.f, sb + 3 <= t ? wa.w : 0.f);
                ww.z = cvt_pk_bf16(sb + 4 <= t ? wb.x : 0.f, sb + 5 <= t ? wb.y : 0.f); ww.w = cvt_pk_bf16(sb + 6 <= t ? wb.z : 0.f, sb + 7 <= t ? wb.w : 0.f);
                wfr[q++] = ww;
            }
        }
    }
#pragma unroll
    for (int hb = 0; hb < 2; ++hb) {
        v4u ld[8][2];
#pragma unroll
        for (int rr = 0; rr < 8; ++rr) { const v4u* p = (const v4u*)(VS + (size_t)(r0 + wave * 16 + hb * 8 + rr) * 1024 + lane * 16); ld[rr][0] = p[0]; ld[rr][1] = p[1]; }
#pragma unroll
        for (int rr = 0; rr < 8; ++rr) {
            float s = 0.f, ss = 0.f;
#pragma unroll
            for (int hh = 0; hh < 2; ++hh) { const v4u w = ld[rr][hh]; const float e[8] = {bf_lo(w.x), bf_hi(w.x), bf_lo(w.y), bf_hi(w.y), bf_lo(w.z), bf_hi(w.z), bf_lo(w.w), bf_hi(w.w)};
#pragma unroll
                for (int i = 0; i < 8; ++i) { s += e[i]; ss += e[i] * e[i]; } }
            s = wave_sum(s); ss = wave_sum(ss);
            const float mean = s * (1.f / 1024.f), var = ss * (1.f / 1024.f) - mean * mean;
            if (lane == 0) { stat[2 * (wave * 16 + hb * 8 + rr)] = mean; stat[2 * (wave * 16 + hb * 8 + rr) + 1] = rsqrtf(var + 1e-6f); }
        }
    }
    __syncthreads();
    LAS unsigned char* vt = lds + SGU_VT + wave * SGU_WREG;
    {
        const int s0 = 2 * lane; const float m0 = stat[2 * s0], rs0 = stat[2 * s0 + 1], m1 = stat[2 * s0 + 2], rs1 = stat[2 * s0 + 3];
#pragma unroll
        for (int i = 0; i < 8; ++i) {
            const int col = colbase + 8 * i;
            const v4u w0 = *(const v4u*)(VS + (size_t)(r0 + s0) * 1024 + col), w1 = *(const v4u*)(VS + (size_t)(r0 + s0 + 1) * 1024 + col);
            const f32x4 lw0 = *(const f32x4*)(lnw + col), lw1 = *(const f32x4*)(lnw + col + 4), lb0 = *(const f32x4*)(lnb + col), lb1 = *(const f32x4*)(lnb + col + 4);
            const float lw[8] = {lw0.x, lw0.y, lw0.z, lw0.w, lw1.x, lw1.y, lw1.z, lw1.w}, lb[8] = {lb0.x, lb0.y, lb0.z, lb0.w, lb1.x, lb1.y, lb1.z, lb1.w};
            const unsigned A0[4] = {w0.x, w0.y, w0.z, w0.w}, A1[4] = {w1.x, w1.y, w1.z, w1.w};
#pragma unroll
            for (int e = 0; e < 8; ++e) { const float v0 = (e & 1) ? bf_hi(A0[e >> 1]) : bf_lo(A0[e >> 1]), v1 = (e & 1) ? bf_hi(A1[e >> 1]) : bf_lo(A1[e >> 1]);
                *(LAS unsigned*)(vt + (8 * i + e) * SGU_VP + s0 * 2) = cvt_pk_bf16((v0 - m0) * rs0 * lw[e] + lb[e], (v1 - m1) * rs1 * lw[e] + lb[e]); }
        }
    }
    LDS_WAIT(); asm volatile("" ::: "memory");
    {
        int q = 0;
#pragma unroll
        for (int mt = 0; mt < 8; ++mt) {
            const int t = 16 * mt + fr;
            v2u uu[4];
#pragma unroll
            for (int nt = 0; nt < 4; ++nt) uu[nt] = *(const v2u*)(U + (size_t)(r0 + t) * 1024 + colbase + 16 * nt + 4 * fq);
            f32x4 acc[4];
#pragma unroll
            for (int nt = 0; nt < 4; ++nt) acc[nt] = (f32x4){0.f, 0.f, 0.f, 0.f};
#pragma unroll
            for (int ks = 0; ks <= (mt >> 1); ++ks) {
                const int sb = 32 * ks + 8 * fq; const bf16x8_t wf = __builtin_bit_cast(bf16x8_t, wfr[q++]);
#pragma unroll
                for (int nt = 0; nt < 4; ++nt) { const bf16x8_t vf = *(const LAS bf16x8_t*)(vt + (16 * nt + fr) * SGU_VP + sb * 2);
                    acc[nt] = __builtin_amdgcn_mfma_f32_16x16x32_bf16(vf, wf, acc[nt], 0, 0, 0); }
            }
            const float bb = bbv[mt];
#pragma unroll
            for (int nt = 0; nt < 4; ++nt) { v2u w; w.x = cvt_pk_bf16(bf_lo(uu[nt].x) * (acc[nt][0] + bb), bf_hi(uu[nt].x) * (acc[nt][1] + bb)); w.y = cvt_pk_bf16(bf_lo(uu[nt].y) * (acc[nt][2] + bb), bf_hi(uu[nt].y) * (acc[nt][3] + bb));
                *(v2u*)(U + (size_t)(r0 + t) * 1024 + colbase + 16 * nt + 4 * fq) = w; }
        }
    }
    __syncthreads();
}
#define XB_TMO      128
#define XB_XCNT(j)  (256  + 64 * (j))
#define XB_XSUB(j)  (1280 + 64 * (j))
#define XB_XGEN(j)  (2304 + 64 * (j))
#define XB_TOP      3328
#define XB_TOPGEN   3392
#define XCD_BAR_WORDS 3456
#define XB_SPIN_CAP (1u << 18)

__device__ __forceinline__ unsigned xb_ld(unsigned* p)              { return __hip_atomic_load(p, __ATOMIC_RELAXED, __HIP_MEMORY_SCOPE_AGENT); }
__device__ __forceinline__ unsigned xb_add(unsigned* p, unsigned v) { return __hip_atomic_fetch_add(p, v, __ATOMIC_RELAXED, __HIP_MEMORY_SCOPE_AGENT); }
__device__ __forceinline__ unsigned xb_xcc_id() { return (unsigned)__builtin_amdgcn_s_getreg((3 << 11) | 20) & 0xFu; }
#define XB_SPIN(cond, bar) do { unsigned _sp = 0; while (cond) { __builtin_amdgcn_s_sleep(1); \
    if ((++_sp & 255u) == 0u) { if (xb_ld(&(bar)[XB_TMO])) break; if (_sp > XB_SPIN_CAP) { atomicAdd(&(bar)[XB_TMO], 1u); break; } } } } while (0)

struct XcdBarrier {
    unsigned* bar; unsigned x;
    volatile LAS unsigned* st;
};

__device__ __forceinline__ XcdBarrier xcd_barrier_post(unsigned* bar, volatile LAS unsigned* st) {
    XcdBarrier b; b.bar = bar; b.x = xb_xcc_id(); b.st = st;
    if (threadIdx.x == 0) (void)xb_add(&bar[XB_XCNT(b.x)], 1u);
    return b;
}
__device__ __forceinline__ void xcd_barrier_complete(unsigned* bar, unsigned x, unsigned& nloc, unsigned& nx) {
    const unsigned G = gridDim.x * gridDim.y * gridDim.z;
    unsigned sum, cnt, mine, sp = 0u;
    for (;;) {
        sum = 0u; cnt = 0u; mine = 0u;
#pragma unroll
        for (unsigned j = 0; j < 16; ++j) { const unsigned c = xb_ld(&bar[XB_XCNT(j)]); sum += c; cnt += (c > 0u) ? 1u : 0u; mine = (j == x) ? c : mine; }
        if (sum == G) break;
        __builtin_amdgcn_s_sleep(1);
        if ((++sp & 255u) == 0u) { if (xb_ld(&bar[XB_TMO])) break; if (sp > XB_SPIN_CAP) { atomicAdd(&bar[XB_TMO], 1u); break; } }
    }
    nloc = mine > 0u ? mine : 1u; nx = cnt > 0u ? cnt : 1u;
}

__device__ __forceinline__ void xcd_barrier(const XcdBarrier& b) {
    asm volatile("s_waitcnt vmcnt(0)" ::: "memory");
    __syncthreads();
    if (threadIdx.x == 0) {
        unsigned* bar = b.bar;
        __builtin_amdgcn_s_waitcnt(0);
        unsigned nloc = b.st[0], nx = b.st[1];
        if (nloc == 0u) { xcd_barrier_complete(bar, b.x, nloc, nx); b.st[0] = nloc; b.st[1] = nx; }
        const unsigned old = xb_add(&bar[XB_XSUB(b.x)], 1u);
        const unsigned gen = old / nloc;
        if (old + 1u == (gen + 1u) * nloc) {
            __builtin_amdgcn_fence(__ATOMIC_RELEASE, "agent");
            asm volatile("s_waitcnt vmcnt(0)" ::: "memory");
            const unsigned og = xb_add(&bar[XB_TOP], 1u);
            const unsigned tg = og / nx;
            if (og + 1u == (tg + 1u) * nx) xb_add(&bar[XB_TOPGEN], 1u);
            else XB_SPIN(xb_ld(&bar[XB_TOPGEN]) == tg, bar);
            __builtin_amdgcn_fence(__ATOMIC_ACQUIRE, "agent");
            xb_add(&bar[XB_XGEN(b.x)], 1u);
            asm volatile("s_waitcnt vmcnt(0)" ::: "memory");
        } else {
            XB_SPIN(xb_ld(&bar[XB_XGEN(b.x)]) == gen, bar);
            __builtin_amdgcn_fence(__ATOMIC_ACQUIRE, "agent");
            asm volatile("s_waitcnt vmcnt(0)" ::: "memory");
        }
    }
    __syncthreads();
}

constexpr size_t WS_BAR = 7 * MiB;
constexpr int XST_OFF = LDS_BYTES - 256, XCH_OFF = 131072;
struct Args { const void* in[22]; float* out; unsigned char* ws; float invf[8]; };

__global__ void __launch_bounds__(512, 2) fwd_mega(Args a) {
    extern __shared__ __attribute__((aligned(16))) unsigned char lds_raw[];
    cg::grid_group grid = cg::this_grid();
    LAS unsigned char* lds = (LAS unsigned char*)lds_raw;
    const int tid = threadIdx.x, lane = tid & 63, wave = __builtin_amdgcn_readfirstlane(tid >> 6);
    const int G = gridDim.x, bx = blockIdx.x;
    const int gw = bx * 8 + wave, NGW = G * 8, gtid = bx * 512 + tid, NTH = G * 512;
#define WSP(off) ((bf16*)(a.ws + (off)))
#define INF(k) ((const float*)a.in[k])
    volatile LAS unsigned* xst = (volatile LAS unsigned*)(lds + XST_OFF);
    if (tid < 2) xst[tid] = 0u;
    unsigned* barw = (unsigned*)(a.ws + WS_BAR);
    if (bx == 0) for (int i = tid; i < XCD_BAR_WORDS; i += 512) __hip_atomic_store(barw + i, 0u, __ATOMIC_RELAXED, __HIP_MEMORY_SCOPE_AGENT);
    XcdBarrier bar; bar.bar = barw; bar.x = 0; bar.st = xst;
    {
        float* cs = (float*)lds_raw; float* red = cs + 4096;
        for (int u = bx; u < 192; u += G) {
            const int l = u / 96, cb = u % 96;
            for (int i = tid; i < 4096; i += 512) { const float v = INF(1)[i]; cs[i] = v / (1.f + __expf(-v)); }
            __syncthreads();
            const int kg = tid >> 6, col = tid & 63, j = cb * 64 + col;
            const float* w = INF(3) + (size_t)l * 1024 * 6144 + (size_t)(kg * 128) * 6144 + j;
            float a0 = 0.f, a1 = 0.f, a2 = 0.f, a3 = 0.f;
#pragma unroll 8
            for (int k = 0; k < 128; ++k) { const float wv = w[(size_t)k * 6144]; const int kk = kg * 128 + k; a0 += cs[kk] * wv; a1 += cs[1024 + kk] * wv; a2 += cs[2048 + kk] * wv; a3 += cs[3072 + kk] * wv; }
            red[(kg * 4 + 0) * 64 + col] = a0; red[(kg * 4 + 1) * 64 + col] = a1; red[(kg * 4 + 2) * 64 + col] = a2; red[(kg * 4 + 3) * 64 + col] = a3;
            __syncthreads();
            if (tid < 256) { const int b = tid >> 6, cc = tid & 63; float s = 0.f;
#pragma unroll
                for (int q = 0; q < 8; ++q) s += red[(q * 4 + b) * 64 + cc];
                ((float*)(a.ws + WS_MOD))[(size_t)(l * 4 + b) * 6144 + cb * 64 + cc] = s + INF(4)[l * 6144 + cb * 64 + cc]; }
            __syncthreads();
        }
        for (int row = gtid; row < M; row += NTH) {
            const float p = (float)((const int*)a.in[2])[row];
#pragma unroll
            for (int d = 0; d < 8; ++d) { const float ang = p * a.invf[d]; const double rev = (double)ang * 0.15915494309189535; const float f = (float)(rev - rint(rev));
                ((float*)(a.ws + WS_ROPE))[(size_t)row * 16 + d] = __builtin_amdgcn_cosf(f); ((float*)(a.ws + WS_ROPE))[(size_t)row * 16 + 8 + d] = __builtin_amdgcn_sinf(f); }
        }
    }

    auto layer_body = [&](auto Lc) __attribute__((always_inline)) {
        constexpr int l = decltype(Lc)::value;
        {
            LAS float* scr = (LAS float*)(lds + wave * 16384);
            for (int it0 = gw; it0 < 8960; it0 += NGW) {
                int it = it0;
                if (it < 2688) { const int kb = it / 168, nb = it % 168; tr_item(INF(6) + (size_t)l * D * INC, INC, WSP(WS_WIN), 1024, 0, 32 * nb, 64 * kb, 32 * nb, scr, lane); continue; } it -= 2688;
                if (it < 512) { const int kb = it / 32, nb = it % 32; tr_item(INF(13) + (size_t)l * D * D, D, WSP(WS_PAB), 1024, 0, 32 * nb, 64 * kb, 32 * nb, scr, lane); continue; } it -= 512;
                if (it < 512) { const int kb = it / 32, nb = it % 32; tr_item(INF(12) + (size_t)l * D * D, D, WSP(WS_PAB), 1024, 0, 1024 + 32 * nb, 64 * kb, 32 * nb, scr, lane); continue; } it -= 512;
                if (it < 1024) { const int cp = it / 512, r = it % 512, kb = r / 32, nb = r % 32; tr_item(INF(14) + (size_t)l * D * D, D, WSP(WS_WO2), 2048, cp * 1024, 32 * nb, 64 * kb, 32 * nb, scr, lane); continue; } it -= 1024;
                if (it < 1408) { const int kb = it / 88, nb = it % 88, n0 = 32 * nb; tr_item(INF(16) + (size_t)l * D * FF, FF, WSP(WS_WGU), 1024, 0, (n0 >> 7) * 256 + (n0 & 127), 64 * kb, n0, scr, lane); continue; } it -= 1408;
                if (it < 1408) { const int kb = it / 88, nb = it % 88, n0 = 32 * nb; tr_item(INF(17) + (size_t)l * D * FF, FF, WSP(WS_WGU), 1024, 0, (n0 >> 7) * 256 + 128 + (n0 & 127), 64 * kb, n0, scr, lane); continue; } it -= 1408;
                { const int kb = it / 32, nb = it % 32; tr_item(INF(20) + (size_t)l * FF * D, D, WSP(WS_WD), 2816, 0, 32 * nb, 64 * kb, 32 * nb, scr, lane); }
            }
        }
        if (l == 0) { grid.sync(); bar = xcd_barrier_post(barw, xst); }
        {
            const float* xin = (l == 0) ? INF(0) : a.out; const float* nw = INF(5) + l * D; const float* ml = (const float*)(a.ws + WS_MOD) + (size_t)l * 4 * 6144;
            for (int m = gw; m < M; m += NGW) {
                const int b = m >> 12; const f32x4* xr = (const f32x4*)(xin + (size_t)m * D) + lane;
                f32x4 v[4]; float ss = 0.f;
#pragma unroll
                for (int j = 0; j < 4; ++j) { v[j] = xr[64 * j]; ss += (v[j].x * v[j].x + v[j].y * v[j].y) + (v[j].z * v[j].z + v[j].w * v[j].w); }
                const float rstd = rsqrtf(wave_sum(ss) * (1.f / D) + 1e-6f);
                v2u* o8 = (v2u*)(WSP(WS_H) + (size_t)m * D) + lane;
#pragma unroll
                for (int j = 0; j < 4; ++j) { const int col = 4 * lane + 256 * j; const f32x4 wv = *(const f32x4*)(nw + col), sh = *(const f32x4*)(ml + (size_t)b * 6144 + col), sc = *(const f32x4*)(ml + (size_t)b * 6144 + 1024 + col);
                    const f32x4 y = (v[j] * rstd) * wv * (sc + 1.0f) + sh; v2u w; w.x = cvt_pk_bf16(y.x, y.y); w.y = cvt_pk_bf16(y.z, y.w); o8[64 * j] = w; }
            }
        }
        xcd_barrier(bar);
        {
            pg8::Gemm g{WSP(WS_H), WSP(WS_WIN), M, INC, D, 1 << 20, 0}; pg8::StaticOrder S; S.init(M, INC, G, bx);
            pg8::EpiInProj E{WSP(WS_Q), WSP(WS_K), WSP(WS_V), WSP(WS_U), WSP(WS_VS), WSP(WS_GA), WSP(WS_GB), (const float*)(a.ws + WS_ROPE)};
            pg8::gemm_phase<pg8::EpiInProj, pg8::StaticOrder, true, true>(lds, g, S, E);
        }
        xcd_barrier(bar);
        {
            int tid_ = threadIdx.x; asm volatile("" : "+v"(tid_));
            for (int it = bx; it < 512; it += G) {
                if (it < 256) attn_unit(lds, WSP(WS_Q), WSP(WS_K), WSP(WS_V), INF(7) + l * 16, it, tid_);
                else sgu_unit(lds, WSP(WS_U), WSP(WS_VS), INF(8) + l * 1024, INF(9) + l * 1024, INF(10) + (size_t)l * 8 * 128 * 128, INF(11) + l * 8 * 128, it - 256, tid_);
            }
        }
        xcd_barrier(bar);
        {
            pg8::Gemm g{WSP(WS_Q), WSP(WS_PAB), M, 2048, D, 4, (size_t)(WS_U - WS_Q)}; pg8::StaticOrder S; S.init(M, 2048, G, bx);
            pg8::EpiGateMul E{WSP(WS_T), WSP(WS_GA), WSP(WS_GB)};
            pg8::gemm_phase<pg8::EpiGateMul, pg8::StaticOrder, true, true>(lds, g, S, E);
        }
        xcd_barrier(bar);
        {
            pg8::Gemm g{WSP(WS_T), WSP(WS_WO2), M, D, 2048, 1 << 20, 0}; pg8::StaticOrder S; S.init(M, D, G, bx);
            pg8::EpiResid E{(l == 0) ? INF(0) : a.out, a.out, (const float*)(a.ws + WS_MOD) + (size_t)l * 4 * 6144 + 2048};
            pg8::gemm_phase<pg8::EpiResid, pg8::StaticOrder, true, true>(lds, g, S, E);
        }
        xcd_barrier(bar);
        {
            const float* nw = INF(15) + l * D; const float* ml = (const float*)(a.ws + WS_MOD) + (size_t)l * 4 * 6144;
            for (int m = gw; m < M; m += NGW) {
                const int b = m >> 12; const f32x4* xr = (const f32x4*)(a.out + (size_t)m * D) + lane;
                f32x4 v[4]; float ss = 0.f;
#pragma unroll
                for (int j = 0; j < 4; ++j) { v[j] = xr[64 * j]; ss += (v[j].x * v[j].x + v[j].y * v[j].y) + (v[j].z * v[j].z + v[j].w * v[j].w); }
                const float rstd = rsqrtf(wave_sum(ss) * (1.f / D) + 1e-6f);
                v2u* o8 = (v2u*)(WSP(WS_H) + (size_t)m * D) + lane;
#pragma unroll
                for (int j = 0; j < 4; ++j) { const int col = 4 * lane + 256 * j; const f32x4 wv = *(const f32x4*)(nw + col), sh = *(const f32x4*)(ml + (size_t)b * 6144 + 3072 + col), sc = *(const f32x4*)(ml + (size_t)b * 6144 + 4096 + col);
                    const f32x4 y = (v[j] * rstd) * wv * (sc + 1.0f) + sh; v2u w; w.x = cvt_pk_bf16(y.x, y.y); w.y = cvt_pk_bf16(y.z, y.w); o8[64 * j] = w; }
            }
        }
        xcd_barrier(bar);
        {
            pg8::Gemm g{WSP(WS_H), WSP(WS_WGU), M, 2 * FF, D, 1 << 20, 0}; pg8::StaticOrder S; S.init(M, 2 * FF, G, bx);
            pg8::EpiGUConv E{WSP(WS_ACT), (float*)(a.ws + WS_RAWA), (float*)(a.ws + WS_RAWU), (float*)(a.ws + WS_TAILA), INF(18) + (size_t)l * 3 * FF, INF(19) + (size_t)l * FF, lds + XCH_OFF};
            pg8::gemm_phase<pg8::EpiGUConv, pg8::StaticOrder, true, true>(lds, g, S, E);
        }
        xcd_barrier(bar);
        {
            pg8::Gemm g{WSP(WS_ACT), WSP(WS_WD), M, D, FF, 1 << 20, 0}; pg8::StaticOrder S; S.init(M, D, G, bx);
            {
                const float* cw = INF(18) + (size_t)l * 3 * FF; const float* cbp = INF(19) + (size_t)l * FF;
                const float* RA = (const float*)(a.ws + WS_RAWA); const float* RU = (const float*)(a.ws + WS_RAWU); const float* TA = (const float*)(a.ws + WS_TAILA);
                pg8::Unit fu;
                for (int i = 0; S.next(i, fu); ++i) {
                    if ((fu.pm & 15) == 0) continue;
                    for (int idx = threadIdx.x; idx < 2 * FF; idx += 512) {
                        const int j = idx / FF, f = idx % FF; const size_t cur = (size_t)fu.pm * 2 * FF, prv = (size_t)(fu.pm - 1) * 2 * FF;
                        const float a2 = RA[cur + j * FF + f], a1 = (j == 0) ? TA[prv + FF + f] : RA[cur + f], a0 = (j == 0) ? TA[prv + f] : TA[prv + FF + f];
                        const float cv = cbp[f] + cw[f] * a0 + cw[FF + f] * a1 + cw[2 * FF + f] * a2;
                        WSP(WS_ACT)[(size_t)(fu.pm * 256 + j) * FF + f] = (bf16)f2bf(cv * pg8::sigm(cv) * RU[cur + j * FF + f]);
                    }
                }
                asm volatile("s_waitcnt vmcnt(0)" ::: "memory"); __syncthreads();
            }
            pg8::EpiResid E{a.out, a.out, (const float*)(a.ws + WS_MOD) + (size_t)l * 4 * 6144 + 5120};
            pg8::gemm_phase<pg8::EpiResid, pg8::StaticOrder, true, true>(lds, g, S, E);
        }
        xcd_barrier(bar);
        };
    layer_body(std::integral_constant<int, 0>{});
    layer_body(std::integral_constant<int, 1>{});
    for (int m = gw; m < M; m += NGW) {
        f32x4* xr = (f32x4*)(a.out + (size_t)m * D) + lane;
        f32x4 v[4]; float ss = 0.f;
#pragma unroll
        for (int j = 0; j < 4; ++j) { v[j] = xr[64 * j]; ss += (v[j].x * v[j].x + v[j].y * v[j].y) + (v[j].z * v[j].z + v[j].w * v[j].w); }
        const float rstd = rsqrtf(wave_sum(ss) * (1.f / D) + 1e-6f);
#pragma unroll
        for (int j = 0; j < 4; ++j) { const f32x4 wv = *(const f32x4*)(INF(21) + 4 * lane + 256 * j); xr[64 * j] = (v[j] * rstd) * wv; }
    }
}

extern "C" void kernel_launch(void* const* d_in, const int* in_sizes, int n_in, void* d_out, int out_size, void* d_ws, size_t ws_size, hipStream_t stream) {
    static int grid = 0;
    if (grid == 0) {
        if (n_in != 22 || out_size != M * D || ws_size < WS_END) { fprintf(stderr, "kernel_launch: unexpected shapes (n_in %d, out %d, ws %zu)\n", n_in, out_size, ws_size); grid = -1; return; }
        int dev = 0, cus = 0, per_cu = 0;
        hipGetDevice(&dev); hipDeviceGetAttribute(&cus, hipDeviceAttributeMultiprocessorCount, dev);
        if (hipFuncSetAttribute((const void*)fwd_mega, hipFuncAttributeMaxDynamicSharedMemorySize, LDS_BYTES) != hipSuccess) { fprintf(stderr, "kernel_launch: hipFuncSetAttribute failed\n"); grid = -1; return; }
        if (hipOccupancyMaxActiveBlocksPerMultiprocessor(&per_cu, (const void*)fwd_mega, 512, LDS_BYTES) != hipSuccess || per_cu < 1) { fprintf(stderr, "kernel_launch: occupancy query gives %d\n", per_cu); per_cu = 1; }
        (void)hipGetLastError();
        grid = cus * (per_cu > 1 ? 1 : per_cu);
    }
    if (grid < 0) return;
    Args a{};
    for (int i = 0; i < 22; ++i) a.in[i] = d_in[i];
    a.out = (float*)d_out; a.ws = (unsigned char*)d_ws;
    for (int d = 0; d < 8; ++d) a.invf[d] = (float)std::pow(500000.0, -(2.0 * d) / 16.0);
    void* args[] = {&a};
    hipError_t e = hipLaunchCooperativeKernel((const void*)fwd_mega, dim3(grid), dim3(512), args, LDS_BYTES, stream);
    if (e != hipSuccess) fprintf(stderr, "cooperative launch failed: %s (grid %d)\n", hipGetErrorString(e), grid);
}
```

```cpp
#include <hip/hip_runtime.h>
#include <hip/hip_cooperative_groups.h>
#include <cstdio>
#include <cstdint>
#include <cmath>
#include <type_traits>
namespace cg = cooperative_groups;
namespace pg8 {
#define PG8_LAS __attribute__((address_space(3)))
typedef unsigned short bf16_t;
typedef short bf16x8 __attribute__((ext_vector_type(8)));
typedef float f32x4 __attribute__((ext_vector_type(4)));
typedef unsigned u32x4 __attribute__((ext_vector_type(4)));
constexpr int BM = 256, BK = 64, HALF = 128, HTB = HALF * BK * 2  , STAGE_BYTES = 8 * HTB, NXCD = 8, WGM = 8;

__host__ __device__ __forceinline__ int lds_byte(int r, int c) { const int st = (r >> 4) * 2 + (c >> 5), rr = r & 15, cc = c & 31, ob = rr * 64 + cc * 2; return st * 1024 + (ob ^ (((ob >> 9) & 1) << 5)); }
__host__ __device__ __forceinline__ void stage_rc(int b, int& R, int& C) { const int st = b / 1024, sb = b % 1024, swz = sb ^ (((sb >> 9) & 1) << 5); R = (st >> 1) * 16 + swz / 64; C = (st & 1) * 32 + (swz % 64) / 2; }
__host__ __device__ __forceinline__ int perm32(int rho) { const int n = rho >> 4, i = rho & 15; return 8 * (i >> 2) + 4 * n + (i & 3); }

struct Unit { int pm, pn; };
struct Gemm { const bf16_t* A; const bf16_t* Bt; int M, N, K; int a_div; size_t a_sel; };

struct StaticOrder {
    int nM, nN, nwg, G, c;
    __host__ __device__ void init(int M, int N, int G_, int c_) { nM = M / BM; nN = N / BM; nwg = nM * nN; G = G_; c = c_; }
    __host__ __device__ bool next(int i, Unit& u) const {
        const long L = (long)i * G + c; if (L >= nwg) return false;
        int wgid = (int)L; { const int q = nwg / NXCD, r = nwg % NXCD, xcd = wgid % NXCD, off = wgid / NXCD; wgid = (xcd < r ? xcd * (q + 1) : r * (q + 1) + (xcd - r) * q) + off; }
        const int nig = WGM * nN, gid = wgid / nig, fm = gid * WGM, gsz = (nM - fm) < WGM ? (nM - fm) : WGM;
        u.pm = fm + ((wgid % nig) % gsz); u.pn = (wgid % nig) / gsz; return true;
    }
    __device__ __forceinline__ void a_ready(const Unit&) const {}
    __device__ __forceinline__ void done(const Unit&) const {}
};

__device__ __forceinline__ unsigned cvt_pk_bf16(float lo, float hi) { unsigned r; asm volatile("v_cvt_pk_bf16_f32 %0, %1, %2" : "=v"(r) : "v"(lo), "v"(hi)); return r; }
typedef float f32x2 __attribute__((ext_vector_type(2)));
__device__ __forceinline__ f32x2 gelu_pk(f32x2 v) {
    const f32x2 av = __builtin_elementwise_abs(v), d = av * 0.2316418882f + 1.0f;
    f32x2 t; t.x = __builtin_amdgcn_rcpf(d.x); t.y = __builtin_amdgcn_rcpf(d.y);
    f32x2 q = t * 0.5307027145f + (-0.7265760135f); q = q * t + 0.7107068705f; q = q * t + (-0.142248368f); q = q * t + 0.127414796f; q = q * t;
    const f32x2 s = (v * v) * (-0.72134752044f);
    f32x2 e; e.x = __builtin_amdgcn_exp2f(s.x); e.y = __builtin_amdgcn_exp2f(s.y);
    const f32x2 m = v * (q * e), r = v - m;
    f32x2 o; o.x = v.x < 0.f ? m.x : r.x; o.y = v.y < 0.f ? m.y : r.y; return o;
}

template <int ACT  > struct EpiBf16 {
    static constexpr bool PERM = true, AFTER_DRAIN = false; static_assert(ACT == 0 || ACT == 1, "EpiBf16: ACT is 0 (none) or 1 (gelu_pk)");
    bf16_t* O; int ldc; const float* bias; int split_cols; size_t split_stride; float scale0;
    __device__ __forceinline__ void operator()(const f32x4 (&acc)[2][2][4][2], const Unit& u, int wr, int wc, int fr, int fq) const {
        const int row0 = u.pm * BM + wr * 64 + fr; int colt = u.pn * BM; bf16_t* base = O;
        float sc = 1.f; if (split_cols) { const int t = colt / split_cols; base += (size_t)t * split_stride; colt -= t * split_cols; if (t == 0) sc = scale0; }
        const int col0 = colt + wc * 32 + 8 * fq, bcol0 = u.pn * BM + wc * 32 + 8 * fq;
        f32x4 bv[2][2];
#pragma unroll
        for (int bj = 0; bj < 2; ++bj)
#pragma unroll
            for (int n = 0; n < 2; ++n) bv[bj][n] = bias ? *(const f32x4*)(bias + bcol0 + bj * HALF + 4 * n) : (f32x4){0.f, 0.f, 0.f, 0.f};
#pragma unroll
        for (int ai = 0; ai < 2; ++ai)
#pragma unroll
            for (int m = 0; m < 4; ++m) { bf16_t* rowp = base + (size_t)(row0 + ai * HALF + m * 16) * ldc + col0;
#pragma unroll
                for (int bj = 0; bj < 2; ++bj) { f32x4 v0 = acc[ai][bj][m][0] + bv[bj][0], v1 = acc[ai][bj][m][1] + bv[bj][1];
                    if (ACT == 1) { f32x2 a = gelu_pk((f32x2){v0[0], v0[1]}), b = gelu_pk((f32x2){v0[2], v0[3]}), c = gelu_pk((f32x2){v1[0], v1[1]}), d = gelu_pk((f32x2){v1[2], v1[3]});
                        v0 = (f32x4){a.x, a.y, b.x, b.y}; v1 = (f32x4){c.x, c.y, d.x, d.y}; }
                    v0 = v0 * sc; v1 = v1 * sc; u32x4 w; w.x = cvt_pk_bf16(v0[0], v0[1]); w.y = cvt_pk_bf16(v0[2], v0[3]); w.z = cvt_pk_bf16(v1[0], v1[1]); w.w = cvt_pk_bf16(v1[2], v1[3]);
                    *(u32x4*)(rowp + bj * HALF) = w; } }
    }
};
template <class Epi, class Sched, bool ALIGN_EPI = false, bool SP2 = false>
__device__ __forceinline__ void gemm_phase(PG8_LAS unsigned char* lds, const Gemm g, const Sched& S, const Epi& E) {
    int tid_ = threadIdx.x; asm volatile("" : "+v"(tid_));
    const int tid = tid_, wid = __builtin_amdgcn_readfirstlane(tid >> 6), lane = tid & 63, wr = wid >> 2, wc = wid & 3, fr = lane & 15, fq = lane >> 4;
    const int K = g.K, nt = K / BK;
    unsigned voffA[2], voffB[2];
#pragma unroll
    for (int i = 0; i < 2; ++i) { int R, C; stage_rc(tid * 16 + i * 8192, R, C); const int Rb = Epi::PERM ? ((R & ~31) + perm32(R & 31)) : R;
        voffA[i] = (unsigned)(R * K + C) * 2u; voffB[i] = (unsigned)(Rb * K + C) * 2u; }
    const size_t kstep = (size_t)(BK * 2);
    const size_t hstep = (size_t)HALF * K * 2;
    const size_t tstep = 2 * hstep;
    const unsigned ldsw = (unsigned)wid * 1024u;
    const int aoff = lds_byte(wr * 64 + fr, fq * 8), boff = lds_byte(wc * 32 + fr, fq * 8);
#define PG8_SA(b, h) (((b) * 2 + (h)) * HTB)
#define PG8_SB(b, h) ((4 + (b) * 2 + (h)) * HTB)
#define PG8_STAGE(bufoff, gbase, voff) do { _Pragma("unroll") for (int _i = 0; _i < 2; ++_i) \
        __builtin_amdgcn_global_load_lds((const unsigned*)((const char*)(gbase) + (voff)[_i]), (PG8_LAS unsigned*)(lds + (bufoff) + ldsw + _i * 8192), 16, 0, 0); } while (0)
#define PG8_LDA(dst, b, h) do { _Pragma("unroll") for (int m = 0; m < 4; ++m) _Pragma("unroll") for (int k = 0; k < 2; ++k) dst[m][k] = *(const PG8_LAS bf16x8*)(lds + PG8_SA(b, h) + aoff + m * 2048 + k * 1024); } while (0)
#define PG8_LDB(dst, b, h) do { _Pragma("unroll") for (int n = 0; n < 2; ++n) _Pragma("unroll") for (int k = 0; k < 2; ++k) dst[n][k] = *(const PG8_LAS bf16x8*)(lds + PG8_SB(b, h) + boff + n * 2048 + k * 1024); } while (0)
#define PG8_MMA(ai, bj, At, Bt) do { __builtin_amdgcn_s_setprio(1); _Pragma("unroll") for (int m = 0; m < 4; ++m) _Pragma("unroll") for (int n = 0; n < 2; ++n) _Pragma("unroll") for (int k = 0; k < 2; ++k) \
        acc[ai][bj][m][n] = __builtin_amdgcn_mfma_f32_16x16x32_bf16(Bt[n][k], At[m][k], acc[ai][bj][m][n], 0, 0, 0); __builtin_amdgcn_s_setprio(0); } while (0)
#define PG8_WAIT_V(n) asm volatile("s_waitcnt vmcnt(" #n ")" ::: "memory")
#define PG8_WAIT_L(n) asm volatile("s_waitcnt lgkmcnt(" #n ")" ::: "memory")
#define PG8_BAR __builtin_amdgcn_s_barrier()
#define PG8_SCHED __builtin_amdgcn_sched_barrier(0)
    Unit cur, nxt; int ui = 0;
    if (!S.next(0, cur)) return;
    f32x4 acc[2][2][4][2];
#pragma unroll
    for (int a = 0; a < 2; ++a)
#pragma unroll
        for (int b = 0; b < 2; ++b)
#pragma unroll
            for (int m = 0; m < 4; ++m)
#pragma unroll
                for (int n = 0; n < 2; ++n) acc[a][b][m][n] = (f32x4){0.f, 0.f, 0.f, 0.f};
    bf16x8 At[4][2], B0[2][2], B1[2][2];
    const char* cA = (const char*)g.A + (size_t)cur.pm * tstep + (size_t)(cur.pn / g.a_div) * g.a_sel; const char* cB = (const char*)g.Bt + (size_t)cur.pn * tstep;
    S.a_ready(cur);
    if constexpr (SP2) {
        PG8_STAGE(PG8_SB(0, 0), cB, voffB); PG8_STAGE(PG8_SB(0, 1), cB + hstep, voffB); PG8_STAGE(PG8_SA(0, 0), cA, voffA); PG8_STAGE(PG8_SA(0, 1), cA + hstep, voffA);
        if (wr == 1) PG8_BAR;
        PG8_WAIT_V(2); PG8_BAR;
        PG8_STAGE(PG8_SB(1, 0), cB + kstep, voffB); PG8_STAGE(PG8_SA(1, 0), cA + kstep, voffA); PG8_STAGE(PG8_SB(1, 1), cB + hstep + kstep, voffB);
        PG8_WAIT_V(6); PG8_BAR;
    } else {
        PG8_STAGE(PG8_SB(0, 0), cB, voffB); PG8_STAGE(PG8_SA(0, 0), cA, voffA); PG8_STAGE(PG8_SB(0, 1), cB + hstep, voffB); PG8_STAGE(PG8_SA(0, 1), cA + hstep, voffA);
        if (wr == 1) PG8_BAR;
        PG8_WAIT_V(4); PG8_BAR;
        PG8_STAGE(PG8_SB(1, 0), cB + kstep, voffB); PG8_STAGE(PG8_SA(1, 0), cA + kstep, voffA); PG8_STAGE(PG8_SB(1, 1), cB + hstep + kstep, voffB);
        PG8_WAIT_V(6); PG8_BAR;
    }
    for (;;) {
        const bool has_next = S.next(ui + 1, nxt);
        const char* nA = has_next ? (const char*)g.A + (size_t)nxt.pm * tstep + (size_t)(nxt.pn / g.a_div) * g.a_sel : cA; const char* nB = has_next ? (const char*)g.Bt + (size_t)nxt.pn * tstep : cB;
        for (int t = 0; t < nt; t += 2) {
            const bool last = (t == nt - 2);
            const char* a1 = cA + (size_t)(t + 1) * kstep;
            const char* a2 = last ? nA : cA + (size_t)(t + 2) * kstep; const char* b2 = last ? nB : cB + (size_t)(t + 2) * kstep;
            const char* a3 = a2 + kstep; const char* b3 = b2 + kstep;
            if (last && has_next) S.a_ready(nxt);
            if constexpr (SP2) {
            PG8_LDB(B0, 0, 0); PG8_LDB(B1, 0, 1); PG8_SCHED; PG8_LDA(At, 0, 0); PG8_STAGE(PG8_SA(1, 1), a1 + hstep, voffA);
            PG8_WAIT_V(8); PG8_WAIT_L(0); PG8_BAR; PG8_MMA(0, 0, At, B0); PG8_MMA(0, 1, At, B1); PG8_BAR; PG8_SCHED;
            PG8_LDA(At, 0, 1); PG8_STAGE(PG8_SB(0, 0), b2, voffB); PG8_STAGE(PG8_SB(0, 1), b2 + hstep, voffB); PG8_STAGE(PG8_SA(0, 0), a2, voffA);
            PG8_WAIT_V(8); PG8_WAIT_L(0); PG8_BAR; PG8_MMA(1, 0, At, B0); PG8_MMA(1, 1, At, B1); PG8_BAR; PG8_SCHED;
            PG8_LDB(B0, 1, 0); PG8_LDB(B1, 1, 1); PG8_SCHED; PG8_LDA(At, 1, 0); PG8_STAGE(PG8_SA(0, 1), a2 + hstep, voffA);
            PG8_WAIT_V(8); PG8_WAIT_L(0); PG8_BAR; PG8_MMA(0, 0, At, B0); PG8_MMA(0, 1, At, B1); PG8_BAR; PG8_SCHED;
            PG8_LDA(At, 1, 1); PG8_STAGE(PG8_SB(1, 0), b3, voffB); PG8_STAGE(PG8_SB(1, 1), b3 + hstep, voffB); PG8_STAGE(PG8_SA(1, 0), a3, voffA);
            PG8_WAIT_V(8); PG8_WAIT_L(0); PG8_BAR; PG8_MMA(1, 0, At, B0); PG8_MMA(1, 1, At, B1); PG8_BAR; PG8_SCHED;
            } else {
            PG8_LDB(B0, 0, 0); PG8_SCHED; PG8_LDA(At, 0, 0); PG8_STAGE(PG8_SA(1, 1), a1 + hstep, voffA);
            PG8_WAIT_L(8); PG8_BAR; PG8_WAIT_L(0); PG8_MMA(0, 0, At, B0); PG8_BAR; PG8_SCHED;
            PG8_LDB(B1, 0, 1); PG8_STAGE(PG8_SB(0, 0), b2, voffB);
            PG8_BAR; PG8_WAIT_L(0); PG8_MMA(0, 1, At, B1); PG8_BAR;
            PG8_LDA(At, 0, 1); PG8_STAGE(PG8_SA(0, 0), a2, voffA);
            PG8_BAR; PG8_WAIT_L(0); PG8_MMA(1, 0, At, B0); PG8_BAR; PG8_SCHED;
            PG8_STAGE(PG8_SB(0, 1), b2 + hstep, voffB);
            PG8_WAIT_V(6); PG8_BAR; PG8_MMA(1, 1, At, B1); PG8_BAR;
            PG8_LDB(B0, 1, 0); PG8_SCHED; PG8_LDA(At, 1, 0); PG8_STAGE(PG8_SA(0, 1), a2 + hstep, voffA);
            PG8_WAIT_L(8); PG8_BAR; PG8_WAIT_L(0); PG8_MMA(0, 0, At, B0); PG8_BAR; PG8_SCHED;
            PG8_LDB(B1, 1, 1); PG8_STAGE(PG8_SB(1, 0), b3, voffB);
            PG8_BAR; PG8_WAIT_L(0); PG8_MMA(0, 1, At, B1); PG8_BAR;
            PG8_LDA(At, 1, 1); PG8_STAGE(PG8_SA(1, 0), a3, voffA);
            PG8_BAR; PG8_WAIT_L(0); PG8_MMA(1, 0, At, B0); PG8_BAR; PG8_SCHED;
            PG8_STAGE(PG8_SB(1, 1), b3 + hstep, voffB);
            PG8_WAIT_V(6); PG8_BAR; PG8_MMA(1, 1, At, B1); PG8_BAR;
            }
        }
        if constexpr (ALIGN_EPI) { if (wr == 0) PG8_BAR; }
        if constexpr (!Epi::AFTER_DRAIN) { E(acc, cur, wr, wc, fr, fq); S.done(cur); }
        if (!has_next) break;
#pragma unroll
        for (int a = 0; a < 2; ++a)
#pragma unroll
            for (int b = 0; b < 2; ++b)
#pragma unroll
                for (int m = 0; m < 4; ++m)
#pragma unroll
                    for (int n = 0; n < 2; ++n) acc[a][b][m][n] = (f32x4){0.f, 0.f, 0.f, 0.f};
        cur = nxt; cA = nA; cB = nB; ++ui;
        if constexpr (ALIGN_EPI) { if (wr == 1) PG8_BAR; }
    }
    PG8_WAIT_V(0);
    if constexpr (!ALIGN_EPI) { if (wr == 0) PG8_BAR; }
    PG8_BAR;
    if constexpr (Epi::AFTER_DRAIN) { E.fused(acc, cur, wr, wc, fr, fq, lds, wid, lane); S.done(cur); }
#undef PG8_SA
#undef PG8_SB
#undef PG8_STAGE
#undef PG8_LDA
#undef PG8_LDB
#undef PG8_MMA
#undef PG8_WAIT_V
#undef PG8_WAIT_L
#undef PG8_BAR
#undef PG8_SCHED
}
}
namespace pg8 {
__device__ __forceinline__ float bf_lo(unsigned w) { return __uint_as_float(w << 16); }
__device__ __forceinline__ float bf_hi(unsigned w) { return __uint_as_float(w & 0xffff0000u); }
__device__ __forceinline__ float sigm(float v) { return __builtin_amdgcn_rcpf(1.0f + __expf(-v)); }
__device__ __forceinline__ u32x4 pack8(f32x4 v0, f32x4 v1) { u32x4 w; w.x = cvt_pk_bf16(v0[0], v0[1]); w.y = cvt_pk_bf16(v0[2], v0[3]); w.z = cvt_pk_bf16(v1[0], v1[1]); w.w = cvt_pk_bf16(v1[2], v1[3]); return w; }

struct EpiInProj {
    static constexpr bool PERM = true, AFTER_DRAIN = false;
    bf16_t *Q, *Kb, *Vb, *U, *VS, *GA, *GB; const float* rope;
    __device__ __forceinline__ void operator()(const f32x4 (&acc)[2][2][4][2], const Unit& u, int wr, int wc, int fr, int fq) const {
        const int pn = u.pn, row0 = u.pm * BM + wr * 64 + fr, cl = wc * 32 + 8 * fq;
        int kind, ldc; bf16_t *b0, *b1;
        if (pn < 4)       { kind = 0; ldc = 1024; b0 = Q + pn * 256 + cl; b1 = b0 + 128; }
        else if (pn == 4) { kind = 1; ldc = 128;  b0 = Kb + cl; b1 = Vb + cl; }
        else if (pn < 9)  { kind = 2; ldc = 1024; b0 = U + (pn - 5) * 256 + cl; b1 = b0 + 128; }
        else if (pn < 13) { kind = 2; ldc = 1024; b0 = VS + (pn - 9) * 256 + cl; b1 = b0 + 128; }
        else if (pn < 17) { kind = 3; ldc = 1024; b0 = GA + (pn - 13) * 256 + cl; b1 = b0 + 128; }
        else              { kind = 3; ldc = 1024; b0 = GB + (pn - 17) * 256 + cl; b1 = b0 + 128; }
        const bool ropelane = ((wc & 1) == 0) && (fq < 2);
        const float sgn = (fq == 0) ? -1.f : 1.f;
#pragma unroll
        for (int ai = 0; ai < 2; ++ai)
#pragma unroll
            for (int m = 0; m < 4; ++m) {
                const int row = row0 + ai * HALF + m * 16;
                f32x4 c0 = {1.f, 1.f, 1.f, 1.f}, c1 = c0, s0 = {0.f, 0.f, 0.f, 0.f}, s1 = s0;
                if (kind <= 1 && ropelane) { const f32x4* rp = (const f32x4*)(rope + (size_t)row * 16); c0 = rp[0]; c1 = rp[1]; s0 = rp[2]; s1 = rp[3]; }
#pragma unroll
                for (int bj = 0; bj < 2; ++bj) {
                    f32x4 v0 = acc[ai][bj][m][0], v1 = acc[ai][bj][m][1];
                    if (kind == 0 || (kind == 1 && bj == 0)) {
                        f32x4 p0, p1;
#pragma unroll
                        for (int i = 0; i < 4; ++i) { p0[i] = __shfl_xor(v0[i], 16); p1[i] = __shfl_xor(v1[i], 16); }
                        v0 = v0 * c0 + (p0 * s0) * sgn; v1 = v1 * c1 + (p1 * s1) * sgn;
                        if (kind == 0) { v0 = v0 * 0.125f; v1 = v1 * 0.125f; }
                    } else if (kind == 2) {
                        f32x2 a = gelu_pk((f32x2){v0[0], v0[1]}), b = gelu_pk((f32x2){v0[2], v0[3]}), c = gelu_pk((f32x2){v1[0], v1[1]}), d = gelu_pk((f32x2){v1[2], v1[3]});
                        v0 = (f32x4){a.x, a.y, b.x, b.y}; v1 = (f32x4){c.x, c.y, d.x, d.y};
                    } else if (kind == 3) {
#pragma unroll
                        for (int i = 0; i < 4; ++i) { v0[i] = sigm(v0[i]); v1[i] = sigm(v1[i]); }
                    }
                    *(u32x4*)((bj ? b1 : b0) + (size_t)row * ldc) = pack8(v0, v1);
                }
            }
    }
};
struct PairOrder {
    StaticOrder base;
    __host__ __device__ void init(int M, int G_, int c_) { base.init(M, 1024, G_, c_); }
    __host__ __device__ bool next(int i, Unit& u) const { Unit b; if (!base.next(i >> 1, b)) return false; u.pm = b.pm; u.pn = b.pn + 4 * (i & 1); return true; }
    __device__ __forceinline__ void a_ready(const Unit&) const {}
    __device__ __forceinline__ void done(const Unit&) const {}
};
struct EpiMerge {
    static constexpr bool PERM = true, AFTER_DRAIN = false;
    bf16_t *P1, *MG; const bf16_t *GA, *GB;
    __device__ __forceinline__ void operator()(const f32x4 (&acc)[2][2][4][2], const Unit& u, int wr, int wc, int fr, int fq) const {
        const int pn = u.pn, row0 = u.pm * BM + wr * 64 + fr, co = (pn & 3) * 256 + wc * 32 + 8 * fq;
        const bf16_t* G = (pn < 4 ? GB : GA) + co;
#pragma unroll
        for (int ai = 0; ai < 2; ++ai)
#pragma unroll
            for (int m = 0; m < 4; ++m) {
                const size_t ro = (size_t)(row0 + ai * HALF + m * 16) * 1024 + co;
#pragma unroll
                for (int bj = 0; bj < 2; ++bj) {
                    const u32x4 g = *(const u32x4*)(G + ro - co + bj * HALF);
                    const f32x4 g0 = {bf_lo(g.x), bf_hi(g.x), bf_lo(g.y), bf_hi(g.y)}, g1 = {bf_lo(g.z), bf_hi(g.z), bf_lo(g.w), bf_hi(g.w)};
                    f32x4 v0 = acc[ai][bj][m][0] * g0, v1 = acc[ai][bj][m][1] * g1;
                    if (pn < 4) { *(u32x4*)(P1 + ro + bj * HALF) = pack8(v0, v1); }
                    else { const u32x4 p = *(const u32x4*)(P1 + ro + bj * HALF);
                        v0 = v0 + (f32x4){bf_lo(p.x), bf_hi(p.x), bf_lo(p.y), bf_hi(p.y)}; v1 = v1 + (f32x4){bf_lo(p.z), bf_hi(p.z), bf_lo(p.w), bf_hi(p.w)};
                        *(u32x4*)(MG + ro + bj * HALF) = pack8(v0, v1); }
                }
            }
    }
};
struct EpiResid {
    static constexpr bool PERM = false, AFTER_DRAIN = false;
    const float* xin; float* out; const float* g;
    __device__ __forceinline__ void operator()(const f32x4 (&acc)[2][2][4][2], const Unit& u, int wr, int wc, int fr, int fq) const {
        const int row0 = u.pm * BM + wr * 64 + fr, col0 = u.pn * BM + wc * 32 + 4 * fq, b = u.pm >> 4;
        f32x4 gv[2][2];
#pragma unroll
        for (int bj = 0; bj < 2; ++bj)
#pragma unroll
            for (int n = 0; n < 2; ++n) gv[bj][n] = *(const f32x4*)(g + (size_t)b * 6144 + col0 + bj * HALF + n * 16);
#pragma unroll
        for (int ai = 0; ai < 2; ++ai)
#pragma unroll
            for (int m = 0; m < 4; ++m) {
                const size_t off = (size_t)(row0 + ai * HALF + m * 16) * 1024 + col0;
#pragma unroll
                for (int bj = 0; bj < 2; ++bj)
#pragma unroll
                    for (int n = 0; n < 2; ++n) { const f32x4 x = *(const f32x4*)(xin + off + bj * HALF + n * 16); *(f32x4*)(out + off + bj * HALF + n * 16) = x + gv[bj][n] * acc[ai][bj][m][n]; }
            }
    }
};
__device__ __forceinline__ float dpp_ctl_shl15(float v) { return __int_as_float(__builtin_amdgcn_update_dpp(0, __float_as_int(v), 0x10F, 0xF, 0xF, false)); }
__device__ __forceinline__ float dpp_ctl_shl14(float v) { return __int_as_float(__builtin_amdgcn_update_dpp(0, __float_as_int(v), 0x10E, 0xF, 0xF, false)); }
__device__ __forceinline__ float dpp_ctl_shr1(float old, float v) { return __int_as_float(__builtin_amdgcn_update_dpp(__float_as_int(old), __float_as_int(v), 0x111, 0xF, 0xF, false)); }
__device__ __forceinline__ float dpp_ctl_shr2(float old, float v) { return __int_as_float(__builtin_amdgcn_update_dpp(__float_as_int(old), __float_as_int(v), 0x112, 0xF, 0xF, false)); }
struct EpiGUConv {
    static constexpr bool PERM = true, AFTER_DRAIN = false;
    bf16_t* ACT; float *RAWA, *RAWU, *TAILA; const float *cw, *cb; PG8_LAS unsigned char* xch;
    __device__ __forceinline__ void operator()(const f32x4 (&acc)[2][2][4][2], const Unit& u, int wr, int wc, int fr, int fq) const {
        const int cl = wc * 32 + 8 * fq, f0 = u.pn * 128 + cl;
        PG8_LAS float* X = (PG8_LAS float*)xch;
        if (fr >= 14) {
#pragma unroll
            for (int ai = 0; ai < 2; ++ai) { PG8_LAS float* p = X + ((ai * 2 + wr) * 2 + (fr - 14)) * 128 + cl; *(PG8_LAS f32x4*)p = acc[ai][0][3][0]; *(PG8_LAS f32x4*)(p + 4) = acc[ai][0][3][1]; }
            if (wr == 1) { float* t = TAILA + ((size_t)u.pm * 2 + (fr - 14)) * 2816 + f0; *(f32x4*)t = acc[1][0][3][0]; *(f32x4*)(t + 4) = acc[1][0][3][1]; }
        }
        if (wr == 0 && fr < 2) { const size_t o = ((size_t)u.pm * 2 + fr) * 2816 + f0;
            *(f32x4*)(RAWA + o) = acc[0][0][0][0]; *(f32x4*)(RAWA + o + 4) = acc[0][0][0][1]; *(f32x4*)(RAWU + o) = acc[0][1][0][0]; *(f32x4*)(RAWU + o + 4) = acc[0][1][0][1]; }
        asm volatile("s_waitcnt lgkmcnt(0)" ::: "memory"); __builtin_amdgcn_s_barrier(); asm volatile("" ::: "memory");
        f32x4 k0[2], k1[2], k2[2], kb[2];
#pragma unroll
        for (int n = 0; n < 2; ++n) { k0[n] = *(const f32x4*)(cw + f0 + 4 * n); k1[n] = *(const f32x4*)(cw + 2816 + f0 + 4 * n); k2[n] = *(const f32x4*)(cw + 2 * 2816 + f0 + 4 * n); kb[n] = *(const f32x4*)(cb + f0 + 4 * n); }
        const int row0 = u.pm * BM + wr * 64 + fr;
#pragma unroll
        for (int ai = 0; ai < 2; ++ai) {
            f32x4 P[2] = {{0.f, 0.f, 0.f, 0.f}, {0.f, 0.f, 0.f, 0.f}};
            if (!(ai == 0 && wr == 0) && fr >= 14) { const int pai = (wr == 1) ? ai : ai - 1, pwr = (wr == 1) ? 0 : 1;
                const PG8_LAS float* p = X + ((pai * 2 + pwr) * 2 + (fr - 14)) * 128 + cl; P[0] = *(const PG8_LAS f32x4*)p; P[1] = *(const PG8_LAS f32x4*)(p + 4); }
#pragma unroll
            for (int m = 0; m < 4; ++m) {
                f32x4 r[2];
#pragma unroll
                for (int n = 0; n < 2; ++n)
#pragma unroll
                    for (int i = 0; i < 4; ++i) {
                        const float cur = acc[ai][0][m][n][i], prev = (m == 0) ? P[n][i] : acc[ai][0][m == 0 ? 0 : m - 1][n][i];
                        const float p1 = dpp_ctl_shr1(dpp_ctl_shl15(prev), cur), p2 = dpp_ctl_shr2(dpp_ctl_shl14(prev), cur);
                        const float cv = kb[n][i] + k0[n][i] * p2 + k1[n][i] * p1 + k2[n][i] * cur;
                        r[n][i] = cv * sigm(cv) * acc[ai][1][m][n][i];
                    }
                *(u32x4*)(ACT + (size_t)(row0 + ai * HALF + m * 16) * 2816 + f0) = pack8(r[0], r[1]);
            }
        }
    }
};
}
#define LAS __attribute__((address_space(3)))
typedef unsigned short bf16;
typedef unsigned v4u __attribute__((ext_vector_type(4)));
typedef unsigned v2u __attribute__((ext_vector_type(2)));
typedef float f32x4 __attribute__((ext_vector_type(4)));
using pg8::bf_lo; using pg8::bf_hi; using pg8::cvt_pk_bf16;

constexpr int M = 16384, D = 1024, SEQ = 4096, INC = 5376, FF = 2816, NL = 2;
constexpr size_t MiB = 1u << 20;
constexpr size_t WS_MOD = 0, WS_ROPE = 1 * MiB, WS_RAWA = 2 * MiB, WS_RAWU = 3 * MiB + 512 * 1024, WS_TAILA = 5 * MiB;
constexpr size_t WS_W = 8 * MiB, WS_WIN = WS_W, WS_PAB = WS_W + 10 * MiB + 512 * 1024, WS_WO2 = WS_PAB + 4 * MiB, WS_WGU = WS_WO2 + 4 * MiB, WS_WD = WS_WGU + 11 * MiB;
constexpr size_t WS_H = 43 * MiB, WS_VS = 75 * MiB, WS_T = 43 * MiB, WS_Q = 107 * MiB, WS_K = 139 * MiB, WS_V = 143 * MiB, WS_U = 147 * MiB, WS_GA = 179 * MiB, WS_GB = 211 * MiB;
constexpr size_t WS_MG = 43 * MiB, WS_P1 = 75 * MiB, WS_ACT = 107 * MiB, WS_END = 256 * MiB;
static_assert(WS_WD + (size_t)D * FF * 2 <= WS_H && WS_GB + 32 * MiB <= WS_END && WS_ACT + 88 * MiB <= WS_END && WS_TAILA + 3 * MiB / 2 <= WS_W, "ws map");
constexpr int LDS_BYTES = 147456;
#define LDS_WAIT() asm volatile("s_waitcnt lgkmcnt(0)" ::: "memory")

__device__ __forceinline__ unsigned f2bf(float f) { unsigned u = __builtin_bit_cast(unsigned, f); return (u + 0x7fffu + ((u >> 16) & 1u)) >> 16; }
__device__ __forceinline__ unsigned pk2(float lo, float hi) { return f2bf(lo) | (f2bf(hi) << 16); }
__device__ __forceinline__ float wave_sum(float v) {
#pragma unroll
    for (int o = 1; o < 64; o <<= 1) v += __shfl_xor(v, o);
    return v;
}
__device__ __forceinline__ void tr_item(const float* W, int N, bf16* WT, int dpitch, int koff, int drow0, int k0, int n0, LAS float* scr, int lane) {
#pragma unroll 8
    for (int i = 0; i < 32; ++i) { const int kk = 2 * i + (lane >> 5); scr[kk * 33 + (lane & 31)] = W[(size_t)(k0 + kk) * N + n0 + (lane & 31)]; }
    LDS_WAIT(); asm volatile("" ::: "memory");
    const int c = lane & 7;
#pragma unroll
    for (int j = 0; j < 4; ++j) { const int n = (lane >> 3) + 8 * j; const LAS float* s = scr + (8 * c) * 33 + n;
        v4u o; o.x = pk2(s[0 * 33], s[1 * 33]); o.y = pk2(s[2 * 33], s[3 * 33]); o.z = pk2(s[4 * 33], s[5 * 33]); o.w = pk2(s[6 * 33], s[7 * 33]);
        *(v4u*)(WT + (size_t)(drow0 + n) * dpitch + koff + k0 + 8 * c) = o; }
    LDS_WAIT(); asm volatile("" ::: "memory");
}

typedef short bf16x8_t __attribute__((ext_vector_type(8)));
constexpr int ATT_KP = 144, ATT_VP = 528, ATT_VOFF = 256 * ATT_KP;
constexpr int SGU_STAT = 0, SGU_VT = 1024, SGU_VP = 272, SGU_WREG = 64 * SGU_VP;
static_assert(ATT_VOFF + 64 * ATT_VP <= 131072 && SGU_VT + 8 * SGU_WREG <= LDS_BYTES, "mixer LDS maps");

__device__ __forceinline__ void attn_unit(LAS unsigned char* lds, bf16* Q, const bf16* Kg, const bf16* Vg, const float* snk, int unit, int tid) {
    const int lane = tid & 63, wave = tid >> 6, fr = lane & 15, fq = lane >> 4;
    const int b = unit >> 6, n = (unit >> 1) & 31, h = unit & 1, r0 = b * SEQ + n * 128, hq = 8 * h + wave;
    const v4u zero4 = {0u, 0u, 0u, 0u};
    bf16* qbase = Q + (size_t)(r0 + fr) * 1024 + hq * 64;
    bf16x8_t qf[8][2];
#pragma unroll
    for (int mt = 0; mt < 8; ++mt) { qf[mt][0] = *(const bf16x8_t*)(qbase + (size_t)mt * 16 * 1024 + 8 * fq); qf[mt][1] = *(const bf16x8_t*)(qbase + (size_t)mt * 16 * 1024 + 32 + 8 * fq); }
#pragma unroll
    for (int i = 0; i < 4; ++i) { const int idx = tid + 512 * i, j = idx >> 3, c = idx & 7, p = n * 128 - 128 + j;
        v4u w = zero4; if (p >= 0) w = *(const v4u*)(Kg + (size_t)(b * SEQ + p) * 128 + h * 64 + c * 8);
        *(LAS v4u*)(lds + j * ATT_KP + c * 16) = w; }
#pragma unroll
    for (int i = 0; i < 2; ++i) { const int idx = tid + 512 * i, j = (idx >> 3) * 2, c = idx & 7, p = n * 128 - 128 + j;
        v4u w0 = zero4, w1 = zero4;
        if (p >= 0) { w0 = *(const v4u*)(Vg + (size_t)(b * SEQ + p) * 128 + h * 64 + c * 8); w1 = *(const v4u*)(Vg + (size_t)(b * SEQ + p + 1) * 128 + h * 64 + c * 8); }
        const unsigned A0[4] = {w0.x, w0.y, w0.z, w0.w}, A1[4] = {w1.x, w1.y, w1.z, w1.w};
#pragma unroll
        for (int e = 0; e < 8; ++e) { const unsigned lo = (e & 1) ? (A0[e >> 1] >> 16) : (A0[e >> 1] & 0xffffu), hi = (e & 1) ? (A1[e >> 1] & 0xffff0000u) : (A1[e >> 1] << 16);
            *(LAS unsigned*)(lds + ATT_VOFF + (8 * c + e) * ATT_VP + j * 2) = lo | hi; } }
    __syncthreads();
    const float sink = snk[hq];
    bool lo_ok[4];
#pragma unroll
    for (int i = 0; i < 4; ++i) lo_ok[i] = (4 * fq + i - fr) > 0;
#pragma unroll
    for (int mt = 0; mt < 8; ++mt) {
        f32x4 st[9];
#pragma unroll
        for (int kb = 0; kb < 9; ++kb) { const LAS unsigned char* kp = lds + (16 * (mt + kb) + fr) * ATT_KP + 16 * fq;
            const bf16x8_t k0 = *(const LAS bf16x8_t*)kp, k1 = *(const LAS bf16x8_t*)(kp + 64);
            f32x4 z = {0.f, 0.f, 0.f, 0.f}; z = __builtin_amdgcn_mfma_f32_16x16x32_bf16(k0, qf[mt][0], z, 0, 0, 0); z = __builtin_amdgcn_mfma_f32_16x16x32_bf16(k1, qf[mt][1], z, 0, 0, 0); st[kb] = z; }
        float mx = sink;
#pragma unroll
        for (int kb = 0; kb < 9; ++kb) {
            const bool tile_ok = (n > 0) || (mt + kb >= 8);
#pragma unroll
            for (int i = 0; i < 4; ++i) { const bool ok = tile_ok && (kb == 0 ? lo_ok[i] : (kb == 8 ? !lo_ok[i] : true));
                st[kb][i] = ok ? st[kb][i] : -INFINITY; mx = fmaxf(mx, st[kb][i]); }
        }
        mx = fmaxf(mx, __shfl_xor(mx, 16)); mx = fmaxf(mx, __shfl_xor(mx, 32));
        float ls = 0.f;
#pragma unroll
        for (int kb = 0; kb < 9; ++kb)
#pragma unroll
            for (int i = 0; i < 4; ++i) { const float p = __expf(st[kb][i] - mx); st[kb][i] = p; ls += p; }
        ls += __shfl_xor(ls, 16); ls += __shfl_xor(ls, 32);
        const float inv = 1.f / (ls + __expf(sink - mx));
        f32x4 o[4];
#pragma unroll
        for (int dt = 0; dt < 4; ++dt) o[dt] = (f32x4){0.f, 0.f, 0.f, 0.f};
#pragma unroll
        for (int kp = 0; kp < 5; ++kp) {
            v4u pw; pw.x = cvt_pk_bf16(st[2 * kp][0], st[2 * kp][1]); pw.y = cvt_pk_bf16(st[2 * kp][2], st[2 * kp][3]);
            if (kp < 4) { pw.z = cvt_pk_bf16(st[(2 * kp + 1) % 9][0], st[(2 * kp + 1) % 9][1]); pw.w = cvt_pk_bf16(st[(2 * kp + 1) % 9][2], st[(2 * kp + 1) % 9][3]); } else { pw.z = 0u; pw.w = 0u; }
            const bf16x8_t pb = __builtin_bit_cast(bf16x8_t, pw);
#pragma unroll
            for (int dt = 0; dt < 4; ++dt) { const LAS unsigned char* vp = lds + ATT_VOFF + (16 * dt + fr) * ATT_VP + (16 * (mt + 2 * kp) + 4 * fq) * 2;
                const v2u lo = *(const LAS v2u*)vp; v2u hi = {0u, 0u}; if (kp < 4) hi = *(const LAS v2u*)(vp + 32);
                v4u aw; aw.x = lo.x; aw.y = lo.y; aw.z = hi.x; aw.w = hi.y;
                o[dt] = __builtin_amdgcn_mfma_f32_16x16x32_bf16(__builtin_bit_cast(bf16x8_t, aw), pb, o[dt], 0, 0, 0); }
        }
#pragma unroll
        for (int dt = 0; dt < 4; ++dt) { const f32x4 y = o[dt] * inv; v2u w; w.x = cvt_pk_bf16(y[0], y[1]); w.y = cvt_pk_bf16(y[2], y[3]); *(v2u*)(qbase + (size_t)mt * 16 * 1024 + 16 * dt + 4 * fq) = w; }
    }
    __syncthreads();
}

__device__ __forceinline__ void sgu_unit(LAS unsigned char* lds, bf16* U, const bf16* VS, const float* lnw, const float* lnb, const float* Wl, const float* bsl, int unit, int tid) {
    const int lane = tid & 63, wave = tid >> 6, fr = lane & 15, fq = lane >> 4;
    const int ch = unit >> 1, hf = unit & 1, r0 = ch * 128, g = 4 * hf + (wave >> 1), colbase = g * 128 + (wave & 1) * 64;
    LAS float* stat = (LAS float*)(lds + SGU_STAT);
    const float* Wg = Wl + (size_t)g * 128 * 128;
    v4u wfr[20]; float bbv[8];
    {
        int q = 0;
#pragma unroll
        for (int mt = 0; mt < 8; ++mt) {
            const int t = 16 * mt + fr; bbv[mt] = bsl[g * 128 + t];
#pragma unroll
            for (int ks = 0; ks <= (mt >> 1); ++ks) {
                const int sb = 32 * ks + 8 * fq;
                const f32x4 wa = *(const f32x4*)(Wg + (size_t)t * 128 + sb), wb = *(const f32x4*)(Wg + (size_t)t * 128 + sb + 4);
                v4u ww;
                ww.x = cvt_pk_bf16(sb + 0 <= t ? wa.x : 0.f, sb + 1 <= t ? wa.y : 0.f); ww.y = cvt_pk_bf16(sb + 2 <= t ? wa.z : 0.f, sb + 3 <= t ? wa.w : 0.f);
                ww.z = cvt_pk_bf16(sb + 4 <= t ? wb.x : 0.f, sb + 5 <= t ? wb.y : 0.f); ww.w = cvt_pk_bf16(sb + 6 <= t ? wb.z : 0.f, sb + 7 <= t ? wb.w : 0.f);
                wfr[q++] = ww;
            }
        }
    }
#pragma unroll
    for (int hb = 0; hb < 2; ++hb) {
        v4u ld[8][2];
#pragma unroll
        for (int rr = 0; rr < 8; ++rr) { const v4u* p = (const v4u*)(VS + (size_t)(r0 + wave * 16 + hb * 8 + rr) * 1024 + lane * 16); ld[rr][0] = p[0]; ld[rr][1] = p[1]; }
#pragma unroll
        for (int rr = 0; rr < 8; ++rr) {
            float s = 0.f, ss = 0.f;
#pragma unroll
            for (int hh = 0; hh < 2; ++hh) { const v4u w = ld[rr][hh]; const float e[8] = {bf_lo(w.x), bf_hi(w.x), bf_lo(w.y), bf_hi(w.y), bf_lo(w.z), bf_hi(w.z), bf_lo(w.w), bf_hi(w.w)};
#pragma unroll
                for (int i = 0; i < 8; ++i) { s += e[i]; ss += e[i] * e[i]; } }
            s = wave_sum(s); ss = wave_sum(ss);
            const float mean = s * (1.f / 1024.f), var = ss * (1.f / 1024.f) - mean * mean;
            if (lane == 0) { stat[2 * (wave * 16 + hb * 8 + rr)] = mean; stat[2 * (wave * 16 + hb * 8 + rr) + 1] = rsqrtf(var + 1e-6f); }
        }
    }
    __syncthreads();
    LAS unsigned char* vt = lds + SGU_VT + wave * SGU_WREG;
    {
        const int s0 = 2 * lane; const float m0 = stat[2 * s0], rs0 = stat[2 * s0 + 1], m1 = stat[2 * s0 + 2], rs1 = stat[2 * s0 + 3];
#pragma unroll
        for (int i = 0; i < 8; ++i) {
            const int col = colbase + 8 * i;
            const v4u w0 = *(const v4u*)(VS + (size_t)(r0 + s0) * 1024 + col), w1 = *(const v4u*)(VS + (size_t)(r0 + s0 + 1) * 1024 + col);
            const f32x4 lw0 = *(const f32x4*)(lnw + col), lw1 = *(const f32x4*)(lnw + col + 4), lb0 = *(const f32x4*)(lnb + col), lb1 = *(const f32x4*)(lnb + col + 4);
            const float lw[8] = {lw0.x, lw0.y, lw0.z, lw0.w, lw1.x, lw1.y, lw1.z, lw1.w}, lb[8] = {lb0.x, lb0.y, lb0.z, lb0.w, lb1.x, lb1.y, lb1.z, lb1.w};
            const unsigned A0[4] = {w0.x, w0.y, w0.z, w0.w}, A1[4] = {w1.x, w1.y, w1.z, w1.w};
#pragma unroll
            for (int e = 0; e < 8; ++e) { const float v0 = (e & 1) ? bf_hi(A0[e >> 1]) : bf_lo(A0[e >> 1]), v1 = (e & 1) ? bf_hi(A1[e >> 1]) : bf_lo(A1[e >> 1]);
                *(LAS unsigned*)(vt + (8 * i + e) * SGU_VP + s0 * 2) = cvt_pk_bf16((v0 - m0) * rs0 * lw[e] + lb[e], (v1 - m1) * rs1 * lw[e] + lb[e]); }
        }
    }
    LDS_WAIT(); asm volatile("" ::: "memory");
    {
        int q = 0;
#pragma unroll
        for (int mt = 0; mt < 8; ++mt) {
            const int t = 16 * mt + fr;
            v2u uu[4];
#pragma unroll
            for (int nt = 0; nt < 4; ++nt) uu[nt] = *(const v2u*)(U + (size_t)(r0 + t) * 1024 + colbase + 16 * nt + 4 * fq);
            f32x4 acc[4];
#pragma unroll
            for (int nt = 0; nt < 4; ++nt) acc[nt] = (f32x4){0.f, 0.f, 0.f, 0.f};
#pragma unroll
            for (int ks = 0; ks <= (mt >> 1); ++ks) {
                const int sb = 32 * ks + 8 * fq; const bf16x8_t wf = __builtin_bit_cast(bf16x8_t, wfr[q++]);
#pragma unroll
                for (int nt = 0; nt < 4; ++nt) { const bf16x8_t vf = *(const LAS bf16x8_t*)(vt + (16 * nt + fr) * SGU_VP + sb * 2);
                    acc[nt] = __builtin_amdgcn_mfma_f32_16x16x32_bf16(vf, wf, acc[nt], 0, 0, 0); }
            }
            const float bb = bbv[mt];
#pragma unroll
            for (int nt = 0; nt < 4; ++nt) { v2u w; w.x = cvt_pk_bf16(bf_lo(uu[nt].x) * (acc[nt][0] + bb), bf_hi(uu[nt].x) * (acc[nt][1] + bb)); w.y = cvt_pk_bf16(bf_lo(uu[nt].y) * (acc[nt][2] + bb), bf_hi(uu[nt].y) * (acc[nt][3] + bb));
                *(v2u*)(U + (size_t)(r0 + t) * 1024 + colbase + 16 * nt + 4 * fq) = w; }
        }
    }
    __syncthreads();
}
#define XB_TMO      128
#define XB_XCNT(j)  (256  + 64 * (j))
#define XB_XSUB(j)  (1280 + 64 * (j))
#define XB_XGEN(j)  (2304 + 64 * (j))
#define XB_TOP      3328
#define XB_TOPGEN   3392
#define XCD_BAR_WORDS 3456
#define XB_SPIN_CAP (1u << 18)

__device__ __forceinline__ unsigned xb_ld(unsigned* p)              { return __hip_atomic_load(p, __ATOMIC_RELAXED, __HIP_MEMORY_SCOPE_AGENT); }
__device__ __forceinline__ unsigned xb_add(unsigned* p, unsigned v) { return __hip_atomic_fetch_add(p, v, __ATOMIC_RELAXED, __HIP_MEMORY_SCOPE_AGENT); }
__device__ __forceinline__ unsigned xb_xcc_id() { return (unsigned)__builtin_amdgcn_s_getreg((3 << 11) | 20) & 0xFu; }
#define XB_SPIN(cond, bar) do { unsigned _sp = 0; while (cond) { __builtin_amdgcn_s_sleep(1); \
    if ((++_sp & 255u) == 0u) { if (xb_ld(&(bar)[XB_TMO])) break; if (_sp > XB_SPIN_CAP) { atomicAdd(&(bar)[XB_TMO], 1u); break; } } } } while (0)

struct XcdBarrier {
    unsigned* bar; unsigned x;
    volatile LAS unsigned* st;
};

__device__ __forceinline__ XcdBarrier xcd_barrier_post(unsigned* bar, volatile LAS unsigned* st) {
    XcdBarrier b; b.bar = bar; b.x = xb_xcc_id(); b.st = st;
    if (threadIdx.x == 0) (void)xb_add(&bar[XB_XCNT(b.x)], 1u);
    return b;
}
__device__ __forceinline__ void xcd_barrier_complete(unsigned* bar, unsigned x, unsigned& nloc, unsigned& nx) {
    const unsigned G = gridDim.x * gridDim.y * gridDim.z;
    unsigned sum, cnt, mine, sp = 0u;
    for (;;) {
        sum = 0u; cnt = 0u; mine = 0u;
#pragma unroll
        for (unsigned j = 0; j < 16; ++j) { const unsigned c = xb_ld(&bar[XB_XCNT(j)]); sum += c; cnt += (c > 0u) ? 1u : 0u; mine = (j == x) ? c : mine; }
        if (sum == G) break;
        __builtin_amdgcn_s_sleep(1);
        if ((++sp & 255u) == 0u) { if (xb_ld(&bar[XB_TMO])) break; if (sp > XB_SPIN_CAP) { atomicAdd(&bar[XB_TMO], 1u); break; } }
    }
    nloc = mine > 0u ? mine : 1u; nx = cnt > 0u ? cnt : 1u;
}

__device__ __forceinline__ void xcd_barrier(const XcdBarrier& b) {
    asm volatile("s_waitcnt vmcnt(0)" ::: "memory");
    __syncthreads();
    if (threadIdx.x == 0) {
        unsigned* bar = b.bar;
        __builtin_amdgcn_s_waitcnt(0);
        unsigned nloc = b.st[0], nx = b.st[1];
        if (nloc == 0u) { xcd_barrier_complete(bar, b.x, nloc, nx); b.st[0] = nloc; b.st[1] = nx; }
        const unsigned old = xb_add(&bar[XB_XSUB(b.x)], 1u);
        const unsigned gen = old / nloc;
        if (old + 1u == (gen + 1u) * nloc) {
            __builtin_amdgcn_fence(__ATOMIC_RELEASE, "agent");
            asm volatile("s_waitcnt vmcnt(0)" ::: "memory");
            const unsigned og = xb_add(&bar[XB_TOP], 1u);
            const unsigned tg = og / nx;
            if (og + 1u == (tg + 1u) * nx) xb_add(&bar[XB_TOPGEN], 1u);
            else XB_SPIN(xb_ld(&bar[XB_TOPGEN]) == tg, bar);
            __builtin_amdgcn_fence(__ATOMIC_ACQUIRE, "agent");
            xb_add(&bar[XB_XGEN(b.x)], 1u);
            asm volatile("s_waitcnt vmcnt(0)" ::: "memory");
        } else {
            XB_SPIN(xb_ld(&bar[XB_XGEN(b.x)]) == gen, bar);
            __builtin_amdgcn_fence(__ATOMIC_ACQUIRE, "agent");
            asm volatile("s_waitcnt vmcnt(0)" ::: "memory");
        }
    }
    __syncthreads();
}

constexpr size_t WS_BAR = 7 * MiB;
constexpr int XST_OFF = LDS_BYTES - 256, XCH_OFF = 131072;
struct Args { const void* in[22]; float* out; unsigned char* ws; float invf[8]; };

__global__ void __launch_bounds__(512, 2) fwd_mega(Args a) {
    extern __shared__ __attribute__((aligned(16))) unsigned char lds_raw[];
    cg::grid_group grid = cg::this_grid();
    LAS unsigned char* lds = (LAS unsigned char*)lds_raw;
    const int tid = threadIdx.x, lane = tid & 63, wave = __builtin_amdgcn_readfirstlane(tid >> 6);
    const int G = gridDim.x, bx = blockIdx.x;
    const int gw = bx * 8 + wave, NGW = G * 8, gtid = bx * 512 + tid, NTH = G * 512;
#define WSP(off) ((bf16*)(a.ws + (off)))
#define INF(k) ((const float*)a.in[k])
    volatile LAS unsigned* xst = (volatile LAS unsigned*)(lds + XST_OFF);
    if (tid < 2) xst[tid] = 0u;
    unsigned* barw = (unsigned*)(a.ws + WS_BAR);
    if (bx == 0) for (int i = tid; i < XCD_BAR_WORDS; i += 512) __hip_atomic_store(barw + i, 0u, __ATOMIC_RELAXED, __HIP_MEMORY_SCOPE_AGENT);
    XcdBarrier bar; bar.bar = barw; bar.x = 0; bar.st = xst;
    {
        float* cs = (float*)lds_raw; float* red = cs + 4096;
        for (int u = bx; u < 192; u += G) {
            const int l = u / 96, cb = u % 96;
            for (int i = tid; i < 4096; i += 512) { const float v = INF(1)[i]; cs[i] = v / (1.f + __expf(-v)); }
            __syncthreads();
            const int kg = tid >> 6, col = tid & 63, j = cb * 64 + col;
            const float* w = INF(3) + (size_t)l * 1024 * 6144 + (size_t)(kg * 128) * 6144 + j;
            float a0 = 0.f, a1 = 0.f, a2 = 0.f, a3 = 0.f;
#pragma unroll 8
            for (int k = 0; k < 128; ++k) { const float wv = w[(size_t)k * 6144]; const int kk = kg * 128 + k; a0 += cs[kk] * wv; a1 += cs[1024 + kk] * wv; a2 += cs[2048 + kk] * wv; a3 += cs[3072 + kk] * wv; }
            red[(kg * 4 + 0) * 64 + col] = a0; red[(kg * 4 + 1) * 64 + col] = a1; red[(kg * 4 + 2) * 64 + col] = a2; red[(kg * 4 + 3) * 64 + col] = a3;
            __syncthreads();
            if (tid < 256) { const int b = tid >> 6, cc = tid & 63; float s = 0.f;
#pragma unroll
                for (int q = 0; q < 8; ++q) s += red[(q * 4 + b) * 64 + cc];
                ((float*)(a.ws + WS_MOD))[(size_t)(l * 4 + b) * 6144 + cb * 64 + cc] = s + INF(4)[l * 6144 + cb * 64 + cc]; }
            __syncthreads();
        }
        for (int row = gtid; row < M; row += NTH) {
            const float p = (float)((const int*)a.in[2])[row];
#pragma unroll
            for (int d = 0; d < 8; ++d) { const float ang = p * a.invf[d]; const double rev = (double)ang * 0.15915494309189535; const float f = (float)(rev - rint(rev));
                ((float*)(a.ws + WS_ROPE))[(size_t)row * 16 + d] = __builtin_amdgcn_cosf(f); ((float*)(a.ws + WS_ROPE))[(size_t)row * 16 + 8 + d] = __builtin_amdgcn_sinf(f); }
        }
    }

    auto layer_body = [&](auto Lc) __attribute__((always_inline)) {
        constexpr int l = decltype(Lc)::value;
        {
            LAS float* scr = (LAS float*)(lds + wave * 16384);
            for (int it0 = gw; it0 < 8448; it0 += NGW) {
                int it = it0;
                if (it < 2688) { const int kb = it / 168, nb = it % 168; tr_item(INF(6) + (size_t)l * D * INC, INC, WSP(WS_WIN), 1024, 0, 32 * nb, 64 * kb, 32 * nb, scr, lane); continue; } it -= 2688;
                if (it < 512) { const int kb = it / 32, nb = it % 32; tr_item(INF(13) + (size_t)l * D * D, D, WSP(WS_PAB), 1024, 0, 32 * nb, 64 * kb, 32 * nb, scr, lane); continue; } it -= 512;
                if (it < 512) { const int kb = it / 32, nb = it % 32; tr_item(INF(12) + (size_t)l * D * D, D, WSP(WS_PAB), 1024, 0, 1024 + 32 * nb, 64 * kb, 32 * nb, scr, lane); continue; } it -= 512;
                if (it < 512) { const int kb = it / 32, nb = it % 32; tr_item(INF(14) + (size_t)l * D * D, D, WSP(WS_WO2), 1024, 0, 32 * nb, 64 * kb, 32 * nb, scr, lane); continue; } it -= 512;
                if (it < 1408) { const int kb = it / 88, nb = it % 88, n0 = 32 * nb; tr_item(INF(16) + (size_t)l * D * FF, FF, WSP(WS_WGU), 1024, 0, (n0 >> 7) * 256 + (n0 & 127), 64 * kb, n0, scr, lane); continue; } it -= 1408;
                if (it < 1408) { const int kb = it / 88, nb = it % 88, n0 = 32 * nb; tr_item(INF(17) + (size_t)l * D * FF, FF, WSP(WS_WGU), 1024, 0, (n0 >> 7) * 256 + 128 + (n0 & 127), 64 * kb, n0, scr, lane); continue; } it -= 1408;
                { const int kb = it / 32, nb = it % 32; tr_item(INF(20) + (size_t)l * FF * D, D, WSP(WS_WD), 2816, 0, 32 * nb, 64 * kb, 32 * nb, scr, lane); }
            }
        }
        if (l == 0) { grid.sync(); bar = xcd_barrier_post(barw, xst); }
        {
            const float* xin = (l == 0) ? INF(0) : a.out; const float* nw = INF(5) + l * D; const float* ml = (const float*)(a.ws + WS_MOD) + (size_t)l * 4 * 6144;
            for (int m = gw; m < M; m += NGW) {
                const int b = m >> 12; const f32x4* xr = (const f32x4*)(xin + (size_t)m * D) + lane;
                f32x4 v[4]; float ss = 0.f;
#pragma unroll
                for (int j = 0; j < 4; ++j) { v[j] = xr[64 * j]; ss += (v[j].x * v[j].x + v[j].y * v[j].y) + (v[j].z * v[j].z + v[j].w * v[j].w); }
                const float rstd = rsqrtf(wave_sum(ss) * (1.f / D) + 1e-6f);
                v2u* o8 = (v2u*)(WSP(WS_H) + (size_t)m * D) + lane;
#pragma unroll
                for (int j = 0; j < 4; ++j) { const int col = 4 * lane + 256 * j; const f32x4 wv = *(const f32x4*)(nw + col), sh = *(const f32x4*)(ml + (size_t)b * 6144 + col), sc = *(const f32x4*)(ml + (size_t)b * 6144 + 1024 + col);
                    const f32x4 y = (v[j] * rstd) * wv * (sc + 1.0f) + sh; v2u w; w.x = cvt_pk_bf16(y.x, y.y); w.y = cvt_pk_bf16(y.z, y.w); o8[64 * j] = w; }
            }
        }
        xcd_barrier(bar);
        {
            pg8::Gemm g{WSP(WS_H), WSP(WS_WIN), M, INC, D, 1 << 20, 0}; pg8::StaticOrder S; S.init(M, INC, G, bx);
            pg8::EpiInProj E{WSP(WS_Q), WSP(WS_K), WSP(WS_V), WSP(WS_U), WSP(WS_VS), WSP(WS_GA), WSP(WS_GB), (const float*)(a.ws + WS_ROPE)};
            pg8::gemm_phase<pg8::EpiInProj, pg8::StaticOrder, true, true>(lds, g, S, E);
        }
        xcd_barrier(bar);
        {
            int tid_ = threadIdx.x; asm volatile("" : "+v"(tid_));
            for (int it = bx; it < 512; it += G) {
                if (it < 256) attn_unit(lds, WSP(WS_Q), WSP(WS_K), WSP(WS_V), INF(7) + l * 16, it, tid_);
                else sgu_unit(lds, WSP(WS_U), WSP(WS_VS), INF(8) + l * 1024, INF(9) + l * 1024, INF(10) + (size_t)l * 8 * 128 * 128, INF(11) + l * 8 * 128, it - 256, tid_);
            }
        }
        xcd_barrier(bar);
        {
            pg8::Gemm g{WSP(WS_Q), WSP(WS_PAB), M, 2048, D, 4, (size_t)(WS_U - WS_Q)}; pg8::PairOrder S; S.init(M, G, bx);
            pg8::EpiMerge E{WSP(WS_P1), WSP(WS_MG), WSP(WS_GA), WSP(WS_GB)};
            pg8::gemm_phase<pg8::EpiMerge, pg8::PairOrder, true, true>(lds, g, S, E);
        }
        xcd_barrier(bar);
        {
            pg8::Gemm g{WSP(WS_MG), WSP(WS_WO2), M, D, D, 1 << 20, 0}; pg8::StaticOrder S; S.init(M, D, G, bx);
            pg8::EpiResid E{(l == 0) ? INF(0) : a.out, a.out, (const float*)(a.ws + WS_MOD) + (size_t)l * 4 * 6144 + 2048};
            pg8::gemm_phase<pg8::EpiResid, pg8::StaticOrder, true, true>(lds, g, S, E);
        }
        xcd_barrier(bar);
        {
            const float* nw = INF(15) + l * D; const float* ml = (const float*)(a.ws + WS_MOD) + (size_t)l * 4 * 6144;
            for (int m = gw; m < M; m += NGW) {
                const int b = m >> 12; const f32x4* xr = (const f32x4*)(a.out + (size_t)m * D) + lane;
                f32x4 v[4]; float ss = 0.f;
#pragma unroll
                for (int j = 0; j < 4; ++j) { v[j] = xr[64 * j]; ss += (v[j].x * v[j].x + v[j].y * v[j].y) + (v[j].z * v[j].z + v[j].w * v[j].w); }
                const float rstd = rsqrtf(wave_sum(ss) * (1.f / D) + 1e-6f);
                v2u* o8 = (v2u*)(WSP(WS_H) + (size_t)m * D) + lane;
#pragma unroll
                for (int j = 0; j < 4; ++j) { const int col = 4 * lane + 256 * j; const f32x4 wv = *(const f32x4*)(nw + col), sh = *(const f32x4*)(ml + (size_t)b * 6144 + 3072 + col), sc = *(const f32x4*)(ml + (size_t)b * 6144 + 4096 + col);
                    const f32x4 y = (v[j] * rstd) * wv * (sc + 1.0f) + sh; v2u w; w.x = cvt_pk_bf16(y.x, y.y); w.y = cvt_pk_bf16(y.z, y.w); o8[64 * j] = w; }
            }
        }
        xcd_barrier(bar);
        {
            pg8::Gemm g{WSP(WS_H), WSP(WS_WGU), M, 2 * FF, D, 1 << 20, 0}; pg8::StaticOrder S; S.init(M, 2 * FF, G, bx);
            pg8::EpiGUConv E{WSP(WS_ACT), (float*)(a.ws + WS_RAWA), (float*)(a.ws + WS_RAWU), (float*)(a.ws + WS_TAILA), INF(18) + (size_t)l * 3 * FF, INF(19) + (size_t)l * FF, lds + XCH_OFF};
            pg8::gemm_phase<pg8::EpiGUConv, pg8::StaticOrder, true, true>(lds, g, S, E);
        }
        xcd_barrier(bar);
        {
            pg8::Gemm g{WSP(WS_ACT), WSP(WS_WD), M, D, FF, 1 << 20, 0}; pg8::StaticOrder S; S.init(M, D, G, bx);
            {
                const float* cw = INF(18) + (size_t)l * 3 * FF; const float* cbp = INF(19) + (size_t)l * FF;
                const float* RA = (const float*)(a.ws + WS_RAWA); const float* RU = (const float*)(a.ws + WS_RAWU); const float* TA = (const float*)(a.ws + WS_TAILA);
                pg8::Unit fu;
                for (int i = 0; S.next(i, fu); ++i) {
                    if ((fu.pm & 15) == 0) continue;
                    for (int idx = threadIdx.x; idx < 2 * FF; idx += 512) {
                        const int j = idx / FF, f = idx % FF; const size_t cur = (size_t)fu.pm * 2 * FF, prv = (size_t)(fu.pm - 1) * 2 * FF;
                        const float a2 = RA[cur + j * FF + f], a1 = (j == 0) ? TA[prv + FF + f] : RA[cur + f], a0 = (j == 0) ? TA[prv + f] : TA[prv + FF + f];
                        const float cv = cbp[f] + cw[f] * a0 + cw[FF + f] * a1 + cw[2 * FF + f] * a2;
                        WSP(WS_ACT)[(size_t)(fu.pm * 256 + j) * FF + f] = (bf16)f2bf(cv * pg8::sigm(cv) * RU[cur + j * FF + f]);
                    }
                }
                asm volatile("s_waitcnt vmcnt(0)" ::: "memory"); __syncthreads();
            }
            pg8::EpiResid E{a.out, a.out, (const float*)(a.ws + WS_MOD) + (size_t)l * 4 * 6144 + 5120};
            pg8::gemm_phase<pg8::EpiResid, pg8::StaticOrder, true, true>(lds, g, S, E);
        }
        xcd_barrier(bar);
        };
    layer_body(std::integral_constant<int, 0>{});
    layer_body(std::integral_constant<int, 1>{});
    for (int m = gw; m < M; m += NGW) {
        f32x4* xr = (f32x4*)(a.out + (size_t)m * D) + lane;
        f32x4 v[4]; float ss = 0.f;
#pragma unroll
        for (int j = 0; j < 4; ++j) { v[j] = xr[64 * j]; ss += (v[j].x * v[j].x + v[j].y * v[j].y) + (v[j].z * v[j].z + v[j].w * v[j].w); }
        const float rstd = rsqrtf(wave_sum(ss) * (1.f / D) + 1e-6f);
#pragma unroll
        for (int j = 0; j < 4; ++j) { const f32x4 wv = *(const f32x4*)(INF(21) + 4 * lane + 256 * j); xr[64 * j] = (v[j] * rstd) * wv; }
    }
}

extern "C" void kernel_launch(void* const* d_in, const int* in_sizes, int n_in, void* d_out, int out_size, void* d_ws, size_t ws_size, hipStream_t stream) {
    static int grid = 0;
    if (grid == 0) {
        if (n_in != 22 || out_size != M * D || ws_size < WS_END) { fprintf(stderr, "kernel_launch: unexpected shapes (n_in %d, out %d, ws %zu)\n", n_in, out_size, ws_size); grid = -1; return; }
        int dev = 0, cus = 0, per_cu = 0;
        hipGetDevice(&dev); hipDeviceGetAttribute(&cus, hipDeviceAttributeMultiprocessorCount, dev);
        if (hipFuncSetAttribute((const void*)fwd_mega, hipFuncAttributeMaxDynamicSharedMemorySize, LDS_BYTES) != hipSuccess) { fprintf(stderr, "kernel_launch: hipFuncSetAttribute failed\n"); grid = -1; return; }
        if (hipOccupancyMaxActiveBlocksPerMultiprocessor(&per_cu, (const void*)fwd_mega, 512, LDS_BYTES) != hipSuccess || per_cu < 1) { fprintf(stderr, "kernel_launch: occupancy query gives %d\n", per_cu); per_cu = 1; }
        (void)hipGetLastError();
        grid = cus * (per_cu > 1 ? 1 : per_cu);
    }
    if (grid < 0) return;
    Args a{};
    for (int i = 0; i < 22; ++i) a.in[i] = d_in[i];
    a.out = (float*)d_out; a.ws = (unsigned char*)d_ws;
    for (int d = 0; d < 8; ++d) a.invf[d] = (float)std::pow(500000.0, -(2.0 * d) / 16.0);
    void* args[] = {&a};
    hipError_t e = hipLaunchCooperativeKernel((const void*)fwd_mega, dim3(grid), dim3(512), args, LDS_BYTES, stream);
    if (e != hipSuccess) fprintf(stderr, "cooperative launch failed: %s (grid %d)\n", hipGetErrorString(e), grid);
}
```
